# Optimizing an MI355X kernel written in HIP

```python
import numpy as np
import jax
import jax.numpy as jnp
from jax import lax

D_MODEL = 1024
BATCH = 8
SEQ = 2048
DEPTH = 1
DEC_BATCH = 16
DEC_SEQ = 4096
PAST_LEN = 128

RW = D_MODEL // 2
RN = 64
RH = RW // RN
DECAY_LORA = 64
AAA_LORA = 64
GATE_LORA = 160
GN_EPS = 64e-5
GW = D_MODEL - RW
GH = 4
GV = GW // GH
GK = GV // 2
GK_LORA = 16
GATE_NORM = 16.0
CHUNK = 64
GLA_EPS = 1e-5
R_COLS = 3 * RW + 2 * DECAY_LORA + 2 * AAA_LORA + GATE_LORA
G_COLS = 2 * GH * GK + GH * GV + GK_LORA + GH * GV
N_IN = R_COLS + G_COLS
N_MEM = 256
X_HEADS = 4
X_HD = D_MODEL // X_HEADS
D_FF = 4 * D_MODEL
NORM_EPS = 1e-6

kernel_name = 'hymba_rwkv7_gla_sandwich_encoder'


def _split(t, sizes):
    return jnp.split(t, np.cumsum(sizes)[:-1].tolist(), axis=-1)


def _rev(t):
    return jnp.flip(t, axis=1)


def rms_norm(x, g, eps=NORM_EPS):
    xf = x.astype(jnp.float32)
    y = xf * lax.rsqrt(jnp.mean(xf * xf, axis=-1, keepdims=True) + eps)
    return (y * g.astype(jnp.float32)).astype(x.dtype)


def centred_shift(p, mu_prev, mu_next):
    prev = jnp.pad(p[:, :-1], ((0, 0), (1, 0), (0, 0)))
    nxt = jnp.pad(p[:, 1:], ((0, 0), (0, 1), (0, 0)))
    return p + mu_prev * (prev - p) + mu_next * (nxt - p)


def rwkv7_scan(r, w, k, v, kk, a):
    B, T, H, N = r.shape

    def step(S, inp):
        r_t, w_t, k_t, v_t, kk_t, a_t = inp
        sa = jnp.einsum('bhij,bhj->bhi', S, -kk_t)
        S = (S * w_t[:, :, None, :] + sa[..., None] * (kk_t * a_t)[:, :, None, :]
             + v_t[..., None] * k_t[:, :, None, :])
        return S, jnp.einsum('bhij,bhj->bhi', S, r_t)

    xs = (jnp.moveaxis(r, 1, 0), jnp.moveaxis(w, 1, 0), jnp.moveaxis(k, 1, 0),
          jnp.moveaxis(v, 1, 0), jnp.moveaxis(kk, 1, 0), jnp.moveaxis(a, 1, 0))
    _, y = lax.scan(step, jnp.zeros((B, H, N, N), r.dtype), xs)
    return jnp.moveaxis(y, 0, 1)


def _rwkv_direction(rh, k, vh, kk, wd, ad, w0, w2, a0, a2, k_a, r_k, reverse):
    B, T, _ = k.shape
    hd = lambda t: t.reshape(B, T, RH, RN)
    w = -jax.nn.softplus(-(w0 + jnp.tanh(wd) @ w2)) - 0.5
    decay = jnp.exp(-jnp.exp(w))
    a = jax.nn.sigmoid(a0 + ad @ a2)
    kd = hd(k * (1.0 + (a - 1.0) * k_a))
    args = (rh, hd(decay), kd, vh, kk, hd(a))
    if reverse:
        y = _rev(rwkv7_scan(*[_rev(t) for t in args]))
    else:
        y = rwkv7_scan(*args)
    bonus = jnp.sum(rh * kd * r_k, axis=-1, keepdims=True) * vh
    return y, bonus


def rwkv7_group(rw, p):
    B, T, _ = rw.shape
    r, k, v, wd_f, wd_b, ad_f, ad_b, gd = _split(
        rw, (RW, RW, RW, DECAY_LORA, DECAY_LORA, AAA_LORA, AAA_LORA, GATE_LORA))
    hd = lambda t: t.reshape(B, T, RH, RN)
    kk = hd(k * p['k_k'])
    kk = kk * lax.rsqrt(jnp.sum(kk * kk, axis=-1, keepdims=True) + 1e-12)
    rh, vh = hd(r), hd(v)
    y_f, b_f = _rwkv_direction(rh, k, vh, kk, wd_f, ad_f, p['w0_f'], p['w2_f'], p['a0_f'], p['a2_f'],
                               p['k_a'], p['r_k'], False)
    y_b, b_b = _rwkv_direction(rh, k, vh, kk, wd_b, ad_b, p['w0_b'], p['w2_b'], p['a0_b'], p['a2_b'],
                               p['k_a'], p['r_k'], True)
    y = y_f + y_b
    mean = jnp.mean(y, axis=-1, keepdims=True)
    var = jnp.mean(jnp.square(y - mean), axis=-1, keepdims=True)
    gn = ((y - mean) * lax.rsqrt(var + GN_EPS)).reshape(B, T, RW) * p['lnx_w'] + p['lnx_b']
    g = jax.nn.sigmoid(gd) @ p['g2']
    return (gn + (b_f + b_b).reshape(B, T, RW)) * g


def gla_chunked(q, k, v, lg):
    B, T, H, dk = q.shape
    dv = v.shape[-1]
    n = T // CHUNK
    c = lambda t: t.reshape(B, n, CHUNK, H, t.shape[-1])
    q, k, v, lg = c(q), c(k), c(v), c(lg)
    b = jnp.cumsum(lg, axis=2)
    b_last = b[:, :, -1]
    q_in = q * jnp.exp(b)
    k_in = k * jnp.exp(-b)
    mask = jnp.tril(jnp.ones((CHUNK, CHUNK), dtype=bool))
    A = jnp.where(mask, jnp.einsum('bnthd,bnshd->bnhts', q_in, k_in), 0.0)
    o_intra = jnp.einsum('bnhts,bnshe->bnthe', A, v)
    dS = jnp.einsum('bnshd,bnshe->bnhde', k * jnp.exp(b_last[:, :, None] - b), v)

    def step(S, inp):
        dec, ds = inp
        return dec[..., None] * S + ds, S

    _, S_prev = lax.scan(step, jnp.zeros((B, H, dk, dv), q.dtype),
                         (jnp.moveaxis(jnp.exp(b_last), 1, 0), jnp.moveaxis(dS, 1, 0)))
    o_inter = jnp.einsum('bnthd,bnhde->bnthe', q_in, jnp.moveaxis(S_prev, 0, 1))
    return (o_intra + o_inter).reshape(B, T, H, dv)


def gla_group(gl, p):
    B, T, _ = gl.shape
    q, k, v, gkd, gg = _split(gl, (GH * GK, GH * GK, GH * GV, GK_LORA, GH * GV))
    q = q.reshape(B, T, GH, GK) * (GK ** -0.5)
    k = k.reshape(B, T, GH, GK)
    v = v.reshape(B, T, GH, GV)
    lg = lambda w2, bias: (jax.nn.log_sigmoid(gkd @ w2 + bias) / GATE_NORM).reshape(B, T, GH, GK)
    o = (gla_chunked(q, k, v, lg(p['gk2_f'], p['gkb_f']))
         + _rev(gla_chunked(_rev(q), _rev(k), _rev(v), _rev(lg(p['gk2_b'], p['gkb_b'])))))
    o = o * lax.rsqrt(jnp.mean(o * o, axis=-1, keepdims=True) + GLA_EPS) * p['gla_norm_w']
    return (o * jax.nn.silu(gg.reshape(B, T, GH, GV))).reshape(B, T, GH * GV)


def hybrid_mixer(h, p):
    proj = h @ p['w_in']
    rw = centred_shift(proj[..., :R_COLS], p['mu_prev'], p['mu_next']).astype(jnp.float32)
    gl = proj[..., R_COLS:].astype(jnp.float32)
    mixed = jnp.concatenate([rwkv7_group(rw, p), gla_group(gl, p)], axis=-1).astype(h.dtype)
    return mixed @ p['w_out']


def cross_attention(h, m, p):
    B, S, _ = h.shape
    M = m.shape[1]
    q = (h @ p['wq_x']).reshape(B, S, X_HEADS, X_HD)
    kv = (m @ p['wkv_x']).reshape(B, M, 2, X_HEADS, X_HD)
    k, v = kv[:, :, 0], kv[:, :, 1]
    s = jnp.einsum('bqhd,bkhd->bhqk', q.astype(jnp.float32), k.astype(jnp.float32)) * (X_HD ** -0.5)
    pr = jax.nn.softmax(s, axis=-1).astype(v.dtype)
    o = jnp.einsum('bhqk,bkhd->bqhd', pr, v).reshape(B, S, D_MODEL)
    return o @ p['wo_x']


def encoder_trunk(x, mem, params):
    for l in range(DEPTH):
        p = {name: w[l] for name, w in params.items()}
        x = x + rms_norm(hybrid_mixer(rms_norm(x, p['g_mix_pre']), p), p['g_mix_post'])
        m = rms_norm(mem, p['g_mem'])
        x = x + rms_norm(cross_attention(rms_norm(x, p['g_x_pre']), m, p), p['g_x_post'])
        h = rms_norm(x, p['g_ffn_pre'])
        x = x + rms_norm(jnp.square(jax.nn.relu(h @ p['w_ff1'])) @ p['w_ff2'], p['g_ffn_post'])
    return x


def setup_inputs(seed: int = 0) -> dict:
    key = jax.random.key(seed)
    ks = jax.random.split(key, 48)
    cnt = [0]

    def nk():
        cnt[0] += 1
        return ks[cnt[0] - 1]

    f32 = jnp.float32
    L = DEPTH

    def nrm(shape, scale):
        return scale * jax.random.normal(nk(), shape, f32)

    def gain(n):
        return 1.0 + nrm((L, n), 0.05)

    def unif(shape, lo, hi):
        return jax.random.uniform(nk(), shape, f32, lo, hi)

    return {
        'x_prompt': nrm((BATCH, SEQ, D_MODEL), 1.0),
        'x_sample': nrm((DEC_BATCH, DEC_SEQ, D_MODEL), 1.0),
        'mem_prompt': nrm((BATCH, N_MEM, D_MODEL), 1.0),
        'mem_sample': nrm((DEC_BATCH, N_MEM, D_MODEL), 1.0),
        'g_mix_pre': gain(D_MODEL),
        'w_in': nrm((L, D_MODEL, N_IN), D_MODEL ** -0.5),
        'mu_prev': unif((L, R_COLS), 0.0, 0.5),
        'mu_next': unif((L, R_COLS), 0.0, 0.5),
        'w0_f': unif((L, RW), -6.0, 0.0),
        'w2_f': nrm((L, DECAY_LORA, RW), 0.1 * DECAY_LORA ** -0.5),
        'w0_b': unif((L, RW), -6.0, 0.0),
        'w2_b': nrm((L, DECAY_LORA, RW), 0.1 * DECAY_LORA ** -0.5),
        'a0_f': nrm((L, RW), 0.1),
        'a2_f': nrm((L, AAA_LORA, RW), 0.1 * AAA_LORA ** -0.5),
        'a0_b': nrm((L, RW), 0.1),
        'a2_b': nrm((L, AAA_LORA, RW), 0.1 * AAA_LORA ** -0.5),
        'g2': nrm((L, GATE_LORA, RW), GATE_LORA ** -0.5),
        'k_k': 0.85 + nrm((L, RW), 0.05),
        'k_a': 1.0 + nrm((L, RW), 0.05),
        'r_k': nrm((L, RH, RN), 0.1),
        'lnx_w': gain(RW),
        'lnx_b': nrm((L, RW), 0.02),
        'gk2_f': nrm((L, GK_LORA, GH * GK), GK_LORA ** -0.5),
        'gkb_f': nrm((L, GH * GK), 0.1),
        'gk2_b': nrm((L, GK_LORA, GH * GK), GK_LORA ** -0.5),
        'gkb_b': nrm((L, GH * GK), 0.1),
        'gla_norm_w': gain(GV),
        'w_out': nrm((L, D_MODEL, D_MODEL), D_MODEL ** -0.5),
        'g_mix_post': gain(D_MODEL),
        'g_x_pre': gain(D_MODEL),
        'g_mem': gain(D_MODEL),
        'wq_x': nrm((L, D_MODEL, D_MODEL), D_MODEL ** -0.5),
        'wkv_x': nrm((L, D_MODEL, 2 * D_MODEL), D_MODEL ** -0.5),
        'wo_x': nrm((L, D_MODEL, D_MODEL), D_MODEL ** -0.5),
        'g_x_post': gain(D_MODEL),
        'g_ffn_pre': gain(D_MODEL),
        'w_ff1': nrm((L, D_MODEL, D_FF), D_MODEL ** -0.5),
        'w_ff2': nrm((L, D_FF, D_MODEL), D_FF ** -0.5),
        'g_ffn_post': gain(D_MODEL),
    }


def reference(x_prompt, x_sample, mem_prompt, mem_sample, g_mix_pre, w_in, mu_prev, mu_next,
              w0_f, w2_f, w0_b, w2_b, a0_f, a2_f, a0_b, a2_b, g2, k_k, k_a, r_k, lnx_w, lnx_b,
              gk2_f, gkb_f, gk2_b, gkb_b, gla_norm_w, w_out, g_mix_post, g_x_pre, g_mem,
              wq_x, wkv_x, wo_x, g_x_post, g_ffn_pre, w_ff1, w_ff2, g_ffn_post):
    params = {
        'g_mix_pre': g_mix_pre, 'w_in': w_in, 'mu_prev': mu_prev, 'mu_next': mu_next,
        'w0_f': w0_f, 'w2_f': w2_f, 'w0_b': w0_b, 'w2_b': w2_b,
        'a0_f': a0_f, 'a2_f': a2_f, 'a0_b': a0_b, 'a2_b': a2_b,
        'g2': g2, 'k_k': k_k, 'k_a': k_a, 'r_k': r_k, 'lnx_w': lnx_w, 'lnx_b': lnx_b,
        'gk2_f': gk2_f, 'gkb_f': gkb_f, 'gk2_b': gk2_b, 'gkb_b': gkb_b, 'gla_norm_w': gla_norm_w,
        'w_out': w_out, 'g_mix_post': g_mix_post, 'g_x_pre': g_x_pre, 'g_mem': g_mem,
        'wq_x': wq_x, 'wkv_x': wkv_x, 'wo_x': wo_x, 'g_x_post': g_x_post,
        'g_ffn_pre': g_ffn_pre, 'w_ff1': w_ff1, 'w_ff2': w_ff2, 'g_ffn_post': g_ffn_post,
    }
    y_prompt = encoder_trunk(x_prompt, mem_prompt, params)
    y_sample = encoder_trunk(x_sample, mem_sample, params)
    return (y_prompt, y_sample)
```

```cpp
#include <hip/hip_runtime.h>
#include <hip/hip_cooperative_groups.h>
#include <cstdio>
namespace cg = cooperative_groups;

#ifndef ONLY
#define ONLY -1
#endif
#define EN(k) (ONLY < 0 || ONLY == (k))
#ifndef SCAN_V
#define SCAN_V 2
#endif
#ifndef DUP_PHASE
#define DUP_PHASE -1
#endif
#ifndef MULTI_LAUNCH
#define MULTI_LAUNCH 0
#endif

#define LAS __attribute__((address_space(3)))
typedef unsigned short bf16_t;
typedef short bf16x8 __attribute__((ext_vector_type(8)));
typedef float f32x4 __attribute__((ext_vector_type(4)));
typedef float f32x2 __attribute__((ext_vector_type(2)));
typedef unsigned u32x4 __attribute__((ext_vector_type(4)));
typedef unsigned u32x2 __attribute__((ext_vector_type(2)));

constexpr int T_ALL = 81920, TP = 16384, TM = 6144, DM = 1024, PROJ_LD = 3504, NPH = 16;
constexpr size_t MiB = 1u << 20;
constexpr size_t WS_SMALL = 1 * MiB;
constexpr int OFF_RS0 = 0, OFF_RSM = T_ALL, OFF_SSQ1 = T_ALL + 8192, OFF_SSQ2 = OFF_SSQ1 + T_ALL, OFF_SSQ3 = OFF_SSQ2 + T_ALL,
              OFF_RS1 = OFF_SSQ3 + T_ALL, OFF_RS2 = OFF_RS1 + T_ALL, OFF_KSC = OFF_RS2 + T_ALL;
constexpr size_t WS_WIN = 8 * MiB, WS_WOUT = 15 * MiB, WS_WQ = 17 * MiB, WS_WKV = 19 * MiB, WS_WO = 23 * MiB, WS_W1 = 25 * MiB, WS_W2 = 33 * MiB, WS_WL = 41 * MiB;
constexpr size_t WS_KB = 44 * MiB, WS_VT = 56 * MiB;
constexpr size_t WS_PROJ = 72 * MiB;
constexpr size_t WS_XB = 620 * MiB, WS_MEMB = 780 * MiB, WS_AL = 620 * MiB, WS_YF = 620 * MiB, WS_GB = 700 * MiB, WS_YB = 780 * MiB, WS_MIXED = 860 * MiB;
constexpr size_t WS_MO = 72 * MiB, WS_Q = 232 * MiB, WS_OB = 392 * MiB, WS_XO = 552 * MiB, WS_HID = 232 * MiB;
constexpr size_t WS_FO_HI = 872 * MiB; constexpr int FO_SPLIT = 4096;
constexpr int LDS_BYTES = 131072 + 256;
#define XCD_BAR_WORDS 3456


typedef __bf16 bf16x2_t __attribute__((ext_vector_type(2)));
__device__ __forceinline__ unsigned pk2(float lo, float hi) { const f32x2 v = {lo, hi}; return __builtin_bit_cast(unsigned, __builtin_convertvector(v, bf16x2_t)); }
__device__ __forceinline__ unsigned f2bf(float f) { return pk2(f, f) & 0xffffu; }
__device__ __forceinline__ float bf2f(unsigned b) { return __builtin_bit_cast(float, (b & 0xffffu) << 16); }
__device__ __forceinline__ float bflo(unsigned w) { return __builtin_bit_cast(float, w << 16); }
__device__ __forceinline__ float bfhi(unsigned w) { return __builtin_bit_cast(float, w & 0xffff0000u); }
__device__ __forceinline__ float wave_sum(float v) {
#pragma unroll
    for (int o = 1; o < 64; o <<= 1) v += __shfl_xor(v, o);
    return v;
}
__device__ __forceinline__ bf16x8 mk8(u32x2 lo, u32x2 hi) { u32x4 w; w.x = lo.x; w.y = lo.y; w.z = hi.x; w.w = hi.y; return __builtin_bit_cast(bf16x8, w); }
__device__ __forceinline__ float sigmoidf_(float z) { return 1.0f / (1.0f + __expf(-z)); }
#define LDS_WAIT() asm volatile("s_waitcnt lgkmcnt(0)" ::: "memory")
#define BAR_LDS() do { asm volatile("s_waitcnt lgkmcnt(0)" ::: "memory"); __builtin_amdgcn_s_barrier(); asm volatile("" ::: "memory"); } while (0)

struct Args { const float* in[39]; float* out; unsigned char* ws; int ph_lo, ph_hi; };
#define GAS __attribute__((address_space(1)))
struct DArgs { const GAS float* in[39]; GAS float* out; GAS unsigned char* ws; int ph_lo, ph_hi; };
typedef const __attribute__((address_space(4))) DArgs* KA;
#define AIN(i) ((const float*)a->in[i])
#define AOUT ((float*)a->out)
#define AWS ((unsigned char*)a->ws)
enum { I_XP = 0, I_XS, I_MP, I_MS, I_G_MIX_PRE, I_W_IN, I_MU_PREV, I_MU_NEXT, I_W0_F, I_W2_F, I_W0_B, I_W2_B, I_A0_F, I_A2_F, I_A0_B, I_A2_B, I_G2, I_K_K, I_K_A, I_R_K,
       I_LNX_W, I_LNX_B, I_GK2_F, I_GKB_F, I_GK2_B, I_GKB_B, I_GLA_NW, I_W_OUT, I_G_MIX_POST, I_G_X_PRE, I_G_MEM, I_WQ, I_WKV, I_WO, I_G_X_POST, I_G_FFN_PRE, I_W_FF1, I_W_FF2, I_G_FFN_POST };

namespace pg8 {
constexpr int BM = 256, BK = 64, HALF = 128, HTB = HALF * BK * 2, STAGE_BYTES = 8 * HTB, NXCD = 8, WGM = 8;
__device__ __forceinline__ int lds_byte(int r, int c) { const int st = (r >> 4) * 2 + (c >> 5), rr = r & 15, cc = c & 31, ob = rr * 64 + cc * 2; return st * 1024 + (ob ^ (((ob >> 9) & 1) << 5)); }
__device__ __forceinline__ void stage_rc(int b, int& R, int& C) { const int st = b / 1024, sb = b % 1024, swz = sb ^ (((sb >> 9) & 1) << 5); R = (st >> 1) * 16 + swz / 64; C = (st & 1) * 32 + (swz % 64) / 2; }
__device__ __forceinline__ int perm32(int rho) { const int n = rho >> 4, i = rho & 15; return 8 * (i >> 2) + 4 * n + (i & 3); }
struct Unit { int pm, pn; };
struct Gemm { const bf16_t* A; const bf16_t* Bt; int M, N, K, lda, ldb; };
struct StaticOrder {
    int nM, nN, nwg, G, c;
    __device__ void init(int M, int N, int G_, int c_) { nM = M / BM; nN = N / BM; nwg = nM * nN; G = G_; c = c_; }
    __device__ bool next(int i, Unit& u) const {
        const long L = (long)i * G + c; if (L >= nwg) return false;
        int wgid = (int)L; { const int q = nwg / NXCD, r = nwg % NXCD, xcd = wgid % NXCD, off = wgid / NXCD; wgid = (xcd < r ? xcd * (q + 1) : r * (q + 1) + (xcd - r) * q) + off; }
        const int nig = WGM * nN, gid = wgid / nig, fm = gid * WGM, gsz = (nM - fm) < WGM ? (nM - fm) : WGM;
        u.pm = fm + ((wgid % nig) % gsz); u.pn = (wgid % nig) / gsz; return true;
    }
};

struct EpiP {
    bf16_t* O; int ldc, ncols; const float* rowscale; const float* colscale; float scal; float* ssq; int act;
    bf16_t* O2; const float* b0; const float* b1; const float* b2; const float* b3;
    bf16_t* Olo; int split;
};
__device__ __forceinline__ void build_epi(KA a, int gi, EpiP& E) {
    unsigned char* ws = AWS; float* sm = (float*)(ws + WS_SMALL);
    E.O = nullptr; E.ldc = 1024; E.ncols = 1 << 30; E.rowscale = nullptr; E.colscale = nullptr; E.scal = 1.0f; E.ssq = nullptr; E.act = 0; E.O2 = nullptr; E.b0 = E.b1 = E.b2 = E.b3 = nullptr; E.Olo = nullptr; E.split = 0;
    switch (gi) {
    case 0: E.O = (bf16_t*)(ws + WS_PROJ); E.ldc = PROJ_LD; E.ncols = PROJ_LD; E.rowscale = sm + OFF_RS0; break;
    case 1: E.O = (bf16_t*)(ws + WS_KB); E.ldc = 1024; E.rowscale = sm + OFF_RSM; break;
    case 2: E.O = (bf16_t*)(ws + WS_VT); E.ldc = TM; E.colscale = sm + OFF_RSM; break;
    case 3: E.O = (bf16_t*)AOUT; E.ldc = 2048; E.act = 2; E.O2 = (bf16_t*)(ws + WS_GB); E.b0 = AIN(I_W0_F); E.b1 = AIN(I_W0_B); E.b2 = AIN(I_A0_F); E.b3 = AIN(I_A0_B); break;
    case 9: E.O = (bf16_t*)(ws + WS_GB); E.ldc = 512; break;
    case 4: E.O = (bf16_t*)(ws + WS_MO); E.ssq = sm + OFF_SSQ1; break;
    case 5: E.O = (bf16_t*)(ws + WS_Q); E.rowscale = sm + OFF_RS1; E.scal = 0.0625f; break;
    case 6: E.O = (bf16_t*)(ws + WS_XO); E.ssq = sm + OFF_SSQ2; break;
    case 7: E.O = (bf16_t*)(ws + WS_HID); E.ldc = 4096; E.rowscale = sm + OFF_RS2; E.act = 1; break;
    default: E.O = (bf16_t*)(ws + WS_FO_HI) - (size_t)FO_SPLIT * 1024; E.Olo = (bf16_t*)(ws + WS_KB); E.split = FO_SPLIT; E.ssq = sm + OFF_SSQ3; break;
    }
}
struct EpiD {
    static constexpr bool PERM = true;
    int gi;
    __device__ __forceinline__ void operator()(const f32x4 (&acc)[2][2][4][2], const Unit& u, int wr, int wc, int fr, int fq) const {
        KA a = (KA)__builtin_amdgcn_kernarg_segment_ptr();
        int gl = gi; asm volatile("" : "+s"(gl), "+s"(a));
        EpiP P; build_epi(a, gl, P);
        const int colbase = u.pn * BM + wc * 32 + 8 * fq;
        const int grp = u.pn >> 1;
        const float* bias = grp == 0 ? P.b0 : (grp == 1 ? P.b1 : (grp == 2 ? P.b2 : P.b3));
#pragma unroll
        for (int ai = 0; ai < 2; ++ai)
#pragma unroll
            for (int m = 0; m < 4; ++m) {
                const int row = u.pm * BM + ai * HALF + wr * 64 + m * 16 + fr;
                const float rsc = P.rowscale ? P.scal * P.rowscale[row] : P.scal;
                float ss = 0.f;
#pragma unroll
                for (int bj = 0; bj < 2; ++bj) {
                    const int col = colbase + bj * HALF;
                    f32x4 v0 = acc[ai][bj][m][0] * rsc, v1 = acc[ai][bj][m][1] * rsc;
                    if (P.colscale) { const f32x4 c0 = *(const f32x4*)(P.colscale + col), c1 = *(const f32x4*)(P.colscale + col + 4); v0 = v0 * c0; v1 = v1 * c1; }
                    if (P.act == 1) {
#pragma unroll
                        for (int j = 0; j < 4; ++j) { const float a0 = v0[j] > 0.f ? v0[j] : 0.f, a1 = v1[j] > 0.f ? v1[j] : 0.f; v0[j] = a0 * a0; v1[j] = a1 * a1; }
                    }
                    bf16_t* dst = (row < P.split ? P.Olo : P.O) + (size_t)row * P.ldc + col;
                    if (P.act == 2) {
                        if (grp < 4) {
                            const int bc = col - grp * 512;
                            const f32x4 c0 = *(const f32x4*)(bias + bc), c1 = *(const f32x4*)(bias + bc + 4);
                            const float mul = grp < 2 ? -0.60653066f : 1.0f;
#pragma unroll
                            for (int j = 0; j < 4; ++j) { v0[j] = mul * sigmoidf_(v0[j] + c0[j]); v1[j] = mul * sigmoidf_(v1[j] + c1[j]); }
                        } else dst = P.O2 + (size_t)row * 512 + (col - 2048);
                    }
                    if (P.ssq) ss += (v0[0] * v0[0] + v0[1] * v0[1]) + (v0[2] * v0[2] + v0[3] * v0[3]) + (v1[0] * v1[0] + v1[1] * v1[1]) + (v1[2] * v1[2] + v1[3] * v1[3]);
                    if (col < P.ncols) { u32x4 w; w.x = pk2(v0[0], v0[1]); w.y = pk2(v0[2], v0[3]); w.z = pk2(v1[0], v1[1]); w.w = pk2(v1[2], v1[3]);
                        if (P.ldc >= 3504) __builtin_nontemporal_store(w, (u32x4*)dst); else *(u32x4*)dst = w; }
                }
                if (P.ssq) { ss += __shfl_xor(ss, 16); ss += __shfl_xor(ss, 32); if (fq == 0) atomicAdd(P.ssq + row, ss); }
            }
    }
};

__device__ __forceinline__ void gemm_phase(LAS unsigned char* lds, const Gemm g, const StaticOrder& S, const EpiD& E, const int tid) {
    const int wid = __builtin_amdgcn_readfirstlane(tid >> 6), lane = tid & 63, wr = wid >> 2, wc = wid & 3, fr = lane & 15, fq = lane >> 4;
    const int K = g.K, nt = K / BK;
    unsigned voffA[2], voffB[2];
#pragma unroll
    for (int i = 0; i < 2; ++i) { int R, C; stage_rc(tid * 16 + i * 8192, R, C); const int Rb = EpiD::PERM ? ((R & ~31) + perm32(R & 31)) : R;
        voffA[i] = (unsigned)(R * g.lda + C) * 2u; voffB[i] = (unsigned)(Rb * g.ldb + C) * 2u; }
    const size_t kstep = (size_t)(BK * 2);
    const size_t hstepA = (size_t)HALF * g.lda * 2, hstepB = (size_t)HALF * g.ldb * 2;
    const size_t tstepA = 2 * hstepA, tstepB = 2 * hstepB;
    const unsigned ldsw = (unsigned)wid * 1024u;
    const int aoff = lds_byte(wr * 64 + fr, fq * 8), boff = lds_byte(wc * 32 + fr, fq * 8);
#define PG8_SA(b, h) (((b) * 2 + (h)) * HTB)
#define PG8_SB(b, h) ((4 + (b) * 2 + (h)) * HTB)
#define PG8_STAGE(bufoff, gbase, voff) do { _Pragma("unroll") for (int _i = 0; _i < 2; ++_i) \
        __builtin_amdgcn_global_load_lds((const unsigned*)((const char*)(gbase) + (voff)[_i]), (LAS unsigned*)(lds + (bufoff) + ldsw + _i * 8192), 16, 0, 0); } while (0)
#define PG8_LDA(dst, b, h) do { _Pragma("unroll") for (int m = 0; m < 4; ++m) _Pragma("unroll") for (int k = 0; k < 2; ++k) dst[m][k] = *(const LAS bf16x8*)(lds + PG8_SA(b, h) + aoff + m * 2048 + k * 1024); } while (0)
#define PG8_LDB(dst, b, h) do { _Pragma("unroll") for (int n = 0; n < 2; ++n) _Pragma("unroll") for (int k = 0; k < 2; ++k) dst[n][k] = *(const LAS bf16x8*)(lds + PG8_SB(b, h) + boff + n * 2048 + k * 1024); } while (0)
#define PG8_MMA(ai, bj, At, Bt) do { __builtin_amdgcn_s_setprio(1); _Pragma("unroll") for (int m = 0; m < 4; ++m) _Pragma("unroll") for (int n = 0; n < 2; ++n) _Pragma("unroll") for (int k = 0; k < 2; ++k) \
        acc[ai][bj][m][n] = __builtin_amdgcn_mfma_f32_16x16x32_bf16(Bt[n][k], At[m][k], acc[ai][bj][m][n], 0, 0, 0); __builtin_amdgcn_s_setprio(0); } while (0)
#define PG8_WAIT_V(n) asm volatile("s_waitcnt vmcnt(" #n ")" ::: "memory")
#define PG8_WAIT_L(n) asm volatile("s_waitcnt lgkmcnt(" #n ")" ::: "memory")
#define PG8_BAR __builtin_amdgcn_s_barrier()
#define PG8_SCHED __builtin_amdgcn_sched_barrier(0)
    Unit cur, nxt; int ui = 0;
    if (!S.next(0, cur)) return;
    f32x4 acc[2][2][4][2];
#pragma unroll
    for (int a = 0; a < 2; ++a)
#pragma unroll
        for (int b = 0; b < 2; ++b)
#pragma unroll
            for (int m = 0; m < 4; ++m)
#pragma unroll
                for (int n = 0; n < 2; ++n) acc[a][b][m][n] = (f32x4){0.f, 0.f, 0.f, 0.f};
    bf16x8 At[4][2], B0[2][2], B1[2][2];
    const char* cA = (const char*)g.A + (size_t)cur.pm * tstepA; const char* cB = (const char*)g.Bt + (size_t)cur.pn * tstepB;
    PG8_STAGE(PG8_SB(0, 0), cB, voffB); PG8_STAGE(PG8_SA(0, 0), cA, voffA); PG8_STAGE(PG8_SB(0, 1), cB + hstepB, voffB); PG8_STAGE(PG8_SA(0, 1), cA + hstepA, voffA);
    if (wr == 1) PG8_BAR;
    PG8_WAIT_V(4); PG8_BAR;
    PG8_STAGE(PG8_SB(1, 0), cB + kstep, voffB); PG8_STAGE(PG8_SA(1, 0), cA + kstep, voffA); PG8_STAGE(PG8_SB(1, 1), cB + hstepB + kstep, voffB);
    PG8_WAIT_V(6); PG8_BAR;
    for (;;) {
        const bool has_next = S.next(ui + 1, nxt);
        const char* nA = has_next ? (const char*)g.A + (size_t)nxt.pm * tstepA : cA; const char* nB = has_next ? (const char*)g.Bt + (size_t)nxt.pn * tstepB : cB;
        for (int t = 0; t < nt; t += 2) {
            const bool last = (t == nt - 2);
            const char* a1 = cA + (size_t)(t + 1) * kstep;
            const char* a2 = last ? nA : cA + (size_t)(t + 2) * kstep; const char* b2 = last ? nB : cB + (size_t)(t + 2) * kstep;
            const char* a3 = a2 + kstep; const char* b3 = b2 + kstep;
            PG8_LDB(B0, 0, 0); PG8_SCHED; PG8_LDA(At, 0, 0); PG8_STAGE(PG8_SA(1, 1), a1 + hstepA, voffA);
            PG8_WAIT_L(8); PG8_BAR; PG8_WAIT_L(0); PG8_MMA(0, 0, At, B0); PG8_BAR; PG8_SCHED;
            PG8_LDB(B1, 0, 1); PG8_STAGE(PG8_SB(0, 0), b2, voffB);
            PG8_BAR; PG8_WAIT_L(0); PG8_MMA(0, 1, At, B1); PG8_BAR;
            PG8_LDA(At, 0, 1); PG8_STAGE(PG8_SA(0, 0), a2, voffA);
            PG8_BAR; PG8_WAIT_L(0); PG8_MMA(1, 0, At, B0); PG8_BAR; PG8_SCHED;
            PG8_STAGE(PG8_SB(0, 1), b2 + hstepB, voffB);
            PG8_WAIT_V(6); PG8_BAR; PG8_MMA(1, 1, At, B1); PG8_BAR;
            PG8_LDB(B0, 1, 0); PG8_SCHED; PG8_LDA(At, 1, 0); PG8_STAGE(PG8_SA(0, 1), a2 + hstepA, voffA);
            PG8_WAIT_L(8); PG8_BAR; PG8_WAIT_L(0); PG8_MMA(0, 0, At, B0); PG8_BAR; PG8_SCHED;
            PG8_LDB(B1, 1, 1); PG8_STAGE(PG8_SB(1, 0), b3, voffB);
            PG8_BAR; PG8_WAIT_L(0); PG8_MMA(0, 1, At, B1); PG8_BAR;
            PG8_LDA(At, 1, 1); PG8_STAGE(PG8_SA(1, 0), a3, voffA);
            PG8_BAR; PG8_WAIT_L(0); PG8_MMA(1, 0, At, B0); PG8_BAR; PG8_SCHED;
            PG8_STAGE(PG8_SB(1, 1), b3 + hstepB, voffB);
            PG8_WAIT_V(6); PG8_BAR; PG8_MMA(1, 1, At, B1); PG8_BAR;
        }
        E(acc, cur, wr, wc, fr, fq);
        if (!has_next) break;
#pragma unroll
        for (int a = 0; a < 2; ++a)
#pragma unroll
            for (int b = 0; b < 2; ++b)
#pragma unroll
                for (int m = 0; m < 4; ++m)
#pragma unroll
                    for (int n = 0; n < 2; ++n) acc[a][b][m][n] = (f32x4){0.f, 0.f, 0.f, 0.f};
        cur = nxt; cA = nA; cB = nB; ++ui;
    }
    PG8_WAIT_V(0);
    if (wr == 0) PG8_BAR;
    PG8_BAR;
#undef PG8_SA
#undef PG8_SB
#undef PG8_STAGE
#undef PG8_LDA
#undef PG8_LDB
#undef PG8_MMA
#undef PG8_WAIT_V
#undef PG8_WAIT_L
#undef PG8_BAR
#undef PG8_SCHED
}
}

__device__ __forceinline__ const float* xrow_ptr(KA a, int t) { return t < TP ? AIN(I_XP) + (size_t)t * DM : AIN(I_XS) + (size_t)(t - TP) * DM; }
__device__ __forceinline__ void seq_pos(int t, int& pos, int& len) { if (t < TP) { pos = t & 2047; len = 2048; } else { pos = (t - TP) & 4095; len = 4096; } }

__device__ __forceinline__ void transpose_item(const float* W, int K, int N, int Npad, bf16_t* WT, const float* g, LAS float* scr, int item, int lane) {
    const int nblk = Npad / 32, kb = item / nblk, nb = item % nblk, k0 = 64 * kb, n0 = 32 * nb;
#pragma unroll 8
    for (int i = 0; i < 32; ++i) { const int kk = 2 * i + (lane >> 5), n = n0 + (lane & 31); float v = (n < N) ? W[(size_t)(k0 + kk) * N + n] : 0.f; if (g) v *= g[k0 + kk]; scr[kk * 33 + (lane & 31)] = v; }
    LDS_WAIT();
    const int c = lane & 7;
#pragma unroll
    for (int j = 0; j < 4; ++j) { const int n = (lane >> 3) + 8 * j; const LAS float* s = scr + (8 * c) * 33 + n;
        u32x4 o; o.x = pk2(s[0 * 33], s[1 * 33]); o.y = pk2(s[2 * 33], s[3 * 33]); o.z = pk2(s[4 * 33], s[5 * 33]); o.w = pk2(s[6 * 33], s[7 * 33]);
        *(u32x4*)(WT + (size_t)(n0 + n) * K + k0 + 8 * c) = o; }
    LDS_WAIT();
}
__device__ __forceinline__ void row_to_bf16(const float* xrow, bf16_t* orow, float* rs, int lane) {
    const f32x4* xr = (const f32x4*)xrow + lane;
    f32x4 v[4]; float s = 0.f;
#pragma unroll
    for (int j = 0; j < 4; ++j) { v[j] = xr[64 * j]; s += (v[j].x * v[j].x + v[j].y * v[j].y) + (v[j].z * v[j].z + v[j].w * v[j].w); }
    s = wave_sum(s);
    u32x2* o8 = (u32x2*)orow + lane;
#pragma unroll
    for (int j = 0; j < 4; ++j) { u32x2 w; w.x = pk2(v[j].x, v[j].y); w.y = pk2(v[j].z, v[j].w); o8[64 * j] = w; }
    if (lane == 0) *rs = 1.0f / sqrtf(s * (1.0f / DM) + 1e-6f);
}
__device__ __forceinline__ void p0_phase(KA a, LAS unsigned char* lds, int G, const int tid, const int bid) {
    const int wid = tid >> 6, lane = tid & 63;
    unsigned char* ws = AWS;
    float* sm = (float*)(ws + WS_SMALL);
    LAS float* scr = (LAS float*)(lds + wid * 8704);
    const int gw = bid * 8 + wid, NGW = G * 8;
    constexpr int I0 = 16 * 112, I1 = 16 * 32, I2 = 16 * 32, I3 = 16 * 64, I4 = 16 * 32, I5 = 16 * 128, I6 = 64 * 32;
    constexpr int NIT = I0 + I1 + I2 + I3 + I4 + I5 + I6;
    for (int it = gw; it < NIT; it += NGW) {
        int r = it;
        if (r < I0) { transpose_item(AIN(I_W_IN), 1024, 3504, 3584, (bf16_t*)(ws + WS_WIN), AIN(I_G_MIX_PRE), scr, r, lane); continue; } r -= I0;
        if (r < I1) { transpose_item(AIN(I_W_OUT), 1024, 1024, 1024, (bf16_t*)(ws + WS_WOUT), nullptr, scr, r, lane); continue; } r -= I1;
        if (r < I2) { transpose_item(AIN(I_WQ), 1024, 1024, 1024, (bf16_t*)(ws + WS_WQ), AIN(I_G_X_PRE), scr, r, lane); continue; } r -= I2;
        if (r < I3) { transpose_item(AIN(I_WKV), 1024, 2048, 2048, (bf16_t*)(ws + WS_WKV), AIN(I_G_MEM), scr, r, lane); continue; } r -= I3;
        if (r < I4) { transpose_item(AIN(I_WO), 1024, 1024, 1024, (bf16_t*)(ws + WS_WO), nullptr, scr, r, lane); continue; } r -= I4;
        if (r < I5) { transpose_item(AIN(I_W_FF1), 1024, 4096, 4096, (bf16_t*)(ws + WS_W1), AIN(I_G_FFN_PRE), scr, r, lane); continue; } r -= I5;
        transpose_item(AIN(I_W_FF2), 4096, 1024, 1024, (bf16_t*)(ws + WS_W2), nullptr, scr, r, lane);
    }
    if (bid == 0) for (int i = tid; i < XCD_BAR_WORDS; i += 512) ((unsigned*)ws)[i] = 0u;
    {
        bf16_t* WL = (bf16_t*)(ws + WS_WL);
        for (int idx = bid * 512 + tid; idx < 2560 * 512; idx += G * 512) {
            const int n = idx >> 9, k = idx & 511; const int grp = n >> 9, nn = n & 511;
            float v = 0.f;
            if (grp < 4) { const int kl = k - grp * 64; if (kl >= 0 && kl < 64) { const float* w = grp == 0 ? AIN(I_W2_F) : (grp == 1 ? AIN(I_W2_B) : (grp == 2 ? AIN(I_A2_F) : AIN(I_A2_B))); v = w[kl * 512 + nn]; } }
            else { const int kl = k - 256; if (kl >= 0 && kl < 160) v = AIN(I_G2)[kl * 512 + nn]; }
            WL[idx] = (bf16_t)f2bf(v);
        }
    }
    bf16_t* XB = (bf16_t*)(ws + WS_XB); bf16_t* MB = (bf16_t*)(ws + WS_MEMB);
    for (int t0 = gw; t0 < T_ALL; t0 += 4 * NGW) {
        f32x4 v[4][4]; int tt[4];
#pragma unroll
        for (int q = 0; q < 4; ++q) { tt[q] = t0 + q * NGW < T_ALL ? t0 + q * NGW : t0; const f32x4* xr = (const f32x4*)xrow_ptr(a, tt[q]) + lane;
#pragma unroll
            for (int j = 0; j < 4; ++j) v[q][j] = __builtin_nontemporal_load(xr + 64 * j); }
#pragma unroll
        for (int q = 0; q < 4; ++q) {
            if (q > 0 && tt[q] == t0) continue;
            float s = 0.f;
#pragma unroll
            for (int j = 0; j < 4; ++j) s += (v[q][j].x * v[q][j].x + v[q][j].y * v[q][j].y) + (v[q][j].z * v[q][j].z + v[q][j].w * v[q][j].w);
            s = wave_sum(s);
            u32x2* o8 = (u32x2*)(XB + (size_t)tt[q] * DM) + lane;
#pragma unroll
            for (int j = 0; j < 4; ++j) { u32x2 w; w.x = pk2(v[q][j].x, v[q][j].y); w.y = pk2(v[q][j].z, v[q][j].w); o8[64 * j] = w; }
            if (lane == 0) sm[OFF_RS0 + tt[q]] = 1.0f / sqrtf(s * (1.0f / DM) + 1e-6f);
        }
    }
    for (int m = gw; m < TM; m += NGW) { const float* mr = m < 2048 ? AIN(I_MP) + (size_t)m * DM : AIN(I_MS) + (size_t)(m - 2048) * DM; row_to_bf16(mr, MB + (size_t)m * DM, sm + OFF_RSM + m, lane); }
    for (int i = bid * 512 + tid; i < 3 * T_ALL; i += G * 512) sm[OFF_SSQ1 + i] = 0.f;
}

__device__ __forceinline__ void ld8nt(const bf16_t* p, float (&o)[8]) { const u32x4 w = __builtin_nontemporal_load((const u32x4*)p); o[0] = bflo(w.x); o[1] = bfhi(w.x); o[2] = bflo(w.y); o[3] = bfhi(w.y); o[4] = bflo(w.z); o[5] = bfhi(w.z); o[6] = bflo(w.w); o[7] = bfhi(w.w); }
__device__ __forceinline__ void ld8(const bf16_t* p, float (&o)[8]) { const u32x4 w = *(const u32x4*)p; o[0] = bflo(w.x); o[1] = bfhi(w.x); o[2] = bflo(w.y); o[3] = bfhi(w.y); o[4] = bflo(w.z); o[5] = bfhi(w.z); o[6] = bflo(w.w); o[7] = bfhi(w.w); }
__device__ __forceinline__ void ldf8(const float* p, float (&o)[8]) { const f32x4 a0 = *(const f32x4*)p, a1 = *(const f32x4*)(p + 4); o[0] = a0.x; o[1] = a0.y; o[2] = a0.z; o[3] = a0.w; o[4] = a1.x; o[5] = a1.y; o[6] = a1.z; o[7] = a1.w; }
__device__ __forceinline__ u32x4 st8(const float (&v)[8]) { u32x4 w; w.x = pk2(v[0], v[1]); w.y = pk2(v[2], v[3]); w.z = pk2(v[4], v[5]); w.w = pk2(v[6], v[7]); return w; }
__device__ __forceinline__ void shift8(const bf16_t* P, int col, bool first, bool last, const float (&mp)[8], const float (&mn)[8], float (&o)[8]) {
    float c[8], pv[8], nx[8];
    ld8(P + col, c); ld8(P + col - (first ? 0 : PROJ_LD), pv); ld8(P + col + (last ? 0 : PROJ_LD), nx);
#pragma unroll
    for (int j = 0; j < 8; ++j) { const float pp = first ? 0.f : pv[j], pn = last ? 0.f : nx[j]; o[j] = c[j] + mp[j] * (pp - c[j]) + mn[j] * (pn - c[j]); }
}
__device__ __forceinline__ void p2_phase(KA a, int G, const int tid, const int bid) {
    const int wid = tid >> 6, lane = tid & 63;
    unsigned char* ws = AWS;
    const bf16_t* PROJ = (const bf16_t*)(ws + WS_PROJ); bf16_t* AL = (bf16_t*)(ws + WS_AL); float* KSC = (float*)(ws + WS_SMALL) + OFF_KSC;
    const int gw = bid * 8 + wid, NGW = G * 8;
    const int lcol = 1536 + 8 * (lane < 52 ? lane : 0), kcol = 512 + 8 * lane;
    float mpl[8], mnl[8], mpk[8], mnk[8], kkv[8];
    ldf8(AIN(I_MU_PREV) + lcol, mpl); ldf8(AIN(I_MU_NEXT) + lcol, mnl); ldf8(AIN(I_MU_PREV) + kcol, mpk); ldf8(AIN(I_MU_NEXT) + kcol, mnk); ldf8(AIN(I_K_K) + 8 * lane, kkv);
    for (int t = gw; t < T_ALL; t += NGW) {
        int pos, len; seq_pos(t, pos, len); const bool first = pos == 0, last = pos == len - 1;
        const bf16_t* P = PROJ + (size_t)t * PROJ_LD;
        float sh[8], kk[8];
        shift8(P, lcol, first, last, mpl, mnl, sh);
        shift8(P, kcol, first, last, mpk, mnk, kk);
        if (lane < 16) {
#pragma unroll
            for (int j = 0; j < 8; ++j) sh[j] = 1.0f - 2.0f / (__expf(2.0f * sh[j]) + 1.0f);
        } else if (lane >= 32) {
#pragma unroll
            for (int j = 0; j < 8; ++j) sh[j] = sigmoidf_(sh[j]);
        }
        if (lane >= 52) {
#pragma unroll
            for (int j = 0; j < 8; ++j) sh[j] = 0.f;
        }
        *(u32x4*)(AL + (size_t)t * 512 + 8 * lane) = st8(sh);
        float s = 0.f;
#pragma unroll
        for (int j = 0; j < 8; ++j) { const float x = kk[j] * kkv[j]; s += x * x; }
        s += __shfl_xor(s, 1); s += __shfl_xor(s, 2); s += __shfl_xor(s, 4);
        if ((lane & 7) == 0) KSC[(size_t)t * 8 + (lane >> 3)] = 1.0f / sqrtf(s + 1e-12f);
    }
}

constexpr int SC_TB = 8;
__device__ __forceinline__ void scan_phase(KA a, LAS unsigned char* lds, int G, const int tid, const int bid) {
    const int wid = __builtin_amdgcn_readfirstlane(tid >> 6), lane = tid & 63;
    unsigned char* ws = AWS;
    const bf16_t* PROJ = (const bf16_t*)(ws + WS_PROJ); const bf16_t* LO = (const bf16_t*)AOUT; const float* KSC = (const float*)(ws + WS_SMALL) + OFF_KSC;
    LAS float* L = (LAS float*)(lds + wid * (SC_TB * 6 * 256));
    for (int u = wid * G + bid; u < 384; u += 8 * G) {
        int row0, len, h, dir;
        if (u < 256) { row0 = TP + (u >> 4) * 4096; len = 4096; h = (u >> 1) & 7; dir = u & 1; }
        else { const int v = u - 256; row0 = (v >> 4) * 2048; len = 2048; h = (v >> 1) & 7; dir = v & 1; }
        const int c = h * 64 + lane;
        const float mpr = AIN(I_MU_PREV)[c], mnr = AIN(I_MU_NEXT)[c], mpk = AIN(I_MU_PREV)[512 + c], mnk = AIN(I_MU_NEXT)[512 + c], mpv = AIN(I_MU_PREV)[1024 + c], mnv = AIN(I_MU_NEXT)[1024 + c];
        const float kkc = AIN(I_K_K)[c], kac = AIN(I_K_A)[c];
        bf16_t* Y = (bf16_t*)(ws + (dir ? WS_YB : WS_YF));
        const int d = dir ? -1 : 1, t0 = dir ? len - 1 : 0;
        float S[64];
#pragma unroll
        for (int j = 0; j < 64; ++j) S[j] = 0.f;
        float rB = 0.f, kB = 0.f, vB = 0.f, rC, kC, vC;
        { const bf16_t* P = PROJ + (size_t)(row0 + t0) * PROJ_LD; rC = bf2f(P[c]); kC = bf2f(P[512 + c]); vC = bf2f(P[1024 + c]); }
        unsigned rawR[SC_TB], rawK[SC_TB], rawV[SC_TB], rawL[SC_TB], rawA[SC_TB]; float rawS[SC_TB];
        const int nb = len / SC_TB;
#define SC_LOAD(b_) do { _Pragma("unroll") for (int s = 0; s < SC_TB; ++s) { const int t = t0 + d * ((b_) * SC_TB + s); int ta = t + d; ta = ta < 0 ? 0 : (ta >= len ? len - 1 : ta); \
            const bf16_t* P = PROJ + (size_t)(row0 + ta) * PROJ_LD; rawR[s] = P[c]; rawK[s] = P[512 + c]; rawV[s] = P[1024 + c]; \
            const bf16_t* Q = LO + (size_t)(row0 + t) * 2048; rawL[s] = Q[dir * 512 + c]; rawA[s] = Q[1024 + dir * 512 + c]; rawS[s] = KSC[(size_t)(row0 + t) * 8 + h]; } } while (0)
        SC_LOAD(0);
        for (int b = 0; b < nb; ++b) {
#pragma unroll
            for (int s = 0; s < SC_TB; ++s) {
                const int t = t0 + d * (b * SC_TB + s); const int ta = t + d; const bool va = ta >= 0 && ta < len;
                const float rA = va ? bf2f(rawR[s]) : 0.f, kA = va ? bf2f(rawK[s]) : 0.f, vA = va ? bf2f(rawV[s]) : 0.f;
                const float rp = dir ? rA : rB, rn = dir ? rB : rA, kp = dir ? kA : kB, kn = dir ? kB : kA, vp = dir ? vA : vB, vn = dir ? vB : vA;
                const float r = rC + mpr * (rp - rC) + mnr * (rn - rC);
                const float k = kC + mpk * (kp - kC) + mnk * (kn - kC);
                const float v = vC + mpv * (vp - vC) + mnv * (vn - vC);
                const float av = bf2f(rawA[s]), w = __expf(bf2f(rawL[s]));
                const float kk = k * kkc * rawS[s];
                LAS float* Ls = L + s * 384;
                Ls[lane] = w; Ls[64 + lane] = kk * av; Ls[128 + lane] = -kk; Ls[192 + lane] = k * (1.0f + (av - 1.0f) * kac); Ls[256 + lane] = r; Ls[320 + lane] = v;
                rB = rC; kB = kC; vB = vC; rC = rA; kC = kA; vC = vA;
            }
            if (b + 1 < nb) SC_LOAD(b + 1);
            LDS_WAIT();
#pragma unroll 2
            for (int s = 0; s < SC_TB; ++s) {
                const LAS float* Ls = L + s * 384;
                const LAS f32x4* W4 = (const LAS f32x4*)Ls; const LAS f32x4* B4 = (const LAS f32x4*)(Ls + 64); const LAS f32x4* N4 = (const LAS f32x4*)(Ls + 128);
                const LAS f32x4* K4 = (const LAS f32x4*)(Ls + 192); const LAS f32x4* R4 = (const LAS f32x4*)(Ls + 256);
                const float v = Ls[320 + lane];
                float s0 = 0.f, s1 = 0.f, s2 = 0.f, s3 = 0.f;
#pragma unroll
                for (int q = 0; q < 16; ++q) { const f32x4 n4 = N4[q]; s0 += S[4 * q] * n4.x; s1 += S[4 * q + 1] * n4.y; s2 += S[4 * q + 2] * n4.z; s3 += S[4 * q + 3] * n4.w; }
                const float sa = (s0 + s1) + (s2 + s3);
                float y0 = 0.f, y1 = 0.f, y2 = 0.f, y3 = 0.f;
#pragma unroll
                for (int q = 0; q < 16; ++q) {
                    const f32x4 w4 = W4[q], b4 = B4[q], k4 = K4[q], r4 = R4[q];
                    S[4 * q]     = S[4 * q]     * w4.x + (sa * b4.x + v * k4.x); y0 += S[4 * q]     * r4.x;
                    S[4 * q + 1] = S[4 * q + 1] * w4.y + (sa * b4.y + v * k4.y); y1 += S[4 * q + 1] * r4.y;
                    S[4 * q + 2] = S[4 * q + 2] * w4.z + (sa * b4.z + v * k4.z); y2 += S[4 * q + 2] * r4.z;
                    S[4 * q + 3] = S[4 * q + 3] * w4.w + (sa * b4.w + v * k4.w); y3 += S[4 * q + 3] * r4.w;
                }
                const int t = t0 + d * (b * SC_TB + s);
                Y[(size_t)(row0 + t) * 512 + c] = (bf16_t)f2bf((y0 + y1) + (y2 + y3));
            }
            LDS_WAIT();
        }
#undef SC_LOAD
    }
}


__device__ __forceinline__ void scan2_phase(KA a, LAS unsigned char* lds, int G, const int tid, const int bid) {
    const int wid = __builtin_amdgcn_readfirstlane(tid >> 6), lane = tid & 63, fr = lane & 15, fq = lane >> 4;
    const int grp = wid >> 2, r = wid & 3;
    const int mid = (r - grp) & 3;
    unsigned char* ws = AWS;
    const bf16_t* PROJ = (const bf16_t*)(ws + WS_PROJ); const bf16_t* LO = (const bf16_t*)AOUT; const float* KSC = (const float*)(ws + WS_SMALL) + OFF_KSC;
    LAS unsigned char* gl0 = lds + grp * 57344;
    const int npair = bid < 128 ? 1 : 2, pbase = bid < 128 ? bid : 128 + 2 * (bid - 128);
    for (int pi = 0; pi < npair; ++pi) {
        const int p = pbase + pi;
        const int u = 2 * p + grp;
        int row0, len, h, dir;
        if (u < 256) { row0 = TP + (u >> 4) * 4096; len = 4096; h = (u >> 1) & 7; dir = u & 1; }
        else { const int v = u - 256; row0 = (v >> 4) * 2048; len = 2048; h = (v >> 1) & 7; dir = v & 1; }
        const int c = h * 64 + lane;
        const float mpr = AIN(I_MU_PREV)[c], mnr = AIN(I_MU_NEXT)[c], mpk = AIN(I_MU_PREV)[512 + c], mnk = AIN(I_MU_NEXT)[512 + c], mpv = AIN(I_MU_PREV)[1024 + c], mnv = AIN(I_MU_NEXT)[1024 + c];
        const float kkc = AIN(I_K_K)[c], kac = AIN(I_K_A)[c];
        bf16_t* Y = (bf16_t*)(ws + (dir ? WS_YB : WS_YF));
        f32x4 accS[4];
#pragma unroll
        for (int j = 0; j < 4; ++j) accS[j] = (f32x4){0.f, 0.f, 0.f, 0.f};
        unsigned rawR[6], rawK[6], rawV[6], rawL[4], rawA[4]; float rawS[4];
        const int nb = len / 16;
#define SC2_LOAD(b_) do { const int tau0 = (b_) * 16 + 4 * r; const int tmin = dir ? len - 4 - tau0 : tau0; \
            _Pragma("unroll") for (int i = 0; i < 4; ++i) { const int t = dir ? len - 1 - tau0 - i : tau0 + i; rawL[i] = LO[(size_t)(row0 + t) * 2048 + dir * 512 + c]; } \
            _Pragma("unroll") for (int m = 0; m < 6; ++m) { int ar = tmin - 1 + m; ar = ar < 0 ? 0 : (ar >= len ? len - 1 : ar); const bf16_t* P = PROJ + (size_t)(row0 + ar) * PROJ_LD; rawR[m] = P[c]; rawK[m] = P[512 + c]; rawV[m] = P[1024 + c]; } \
            _Pragma("unroll") for (int i = 0; i < 4; ++i) { const int t = dir ? len - 1 - tau0 - i : tau0 + i; const bf16_t* Q = LO + (size_t)(row0 + t) * 2048; rawA[i] = Q[1024 + dir * 512 + c]; rawS[i] = KSC[(size_t)(row0 + t) * 8 + h]; } } while (0)
        SC2_LOAD(0);
        { LAS float* tot0 = (LAS float*)(gl0 + 24576 - 1024);
          tot0[r * 64 + lane] = (bf2f(rawL[0]) + bf2f(rawL[1])) + (bf2f(rawL[2]) + bf2f(rawL[3])); }
        BAR_LDS();
        for (int b = 0; b < nb; ++b) {
            LAS unsigned char* gl = gl0 + (b & 1) * 28672;
            LAS bf16_t* At = (LAS bf16_t*)gl; LAS bf16_t* Rt = At + 16 * 72; LAS bf16_t* Bs = Rt + 16 * 72; LAS bf16_t* Ks = Bs + 16 * 72;
            LAS bf16_t* BT = Ks + 16 * 72; LAS bf16_t* KT = BT + 64 * 24; LAS bf16_t* VT = KT + 64 * 24;
            LAS bf16_t* MkaT = VT + 64 * 24; LAS bf16_t* MbrT = MkaT + 16 * 24; LAS bf16_t* MkrT = MbrT + 16 * 24;
            LAS float* Nf = (LAS float*)(MkrT + 16 * 24); LAS float* TTf = Nf + 16 * 20; LAS float* Pc = TTf + 16 * 20; LAS float* tot = Pc + 64;
            const int tau0 = b * 16 + 4 * r; const int tmin = dir ? len - 4 - tau0 : tau0;
            float xr[6], xk[6], xv[6];
#pragma unroll
            for (int m = 0; m < 6; ++m) { const int ar = tmin - 1 + m; const bool ok = ar >= 0 && ar < len; xr[m] = ok ? bf2f(rawR[m]) : 0.f; xk[m] = ok ? bf2f(rawK[m]) : 0.f; xv[m] = ok ? bf2f(rawV[m]) : 0.f; }
            float Lv[4], cl[4];
#pragma unroll
            for (int i = 0; i < 4; ++i) { Lv[i] = bf2f(rawL[i]); cl[i] = i ? cl[i - 1] + Lv[i] : Lv[i]; }
            float off = 0.f, all = 0.f;
#pragma unroll
            for (int w2 = 0; w2 < 4; ++w2) { const float x = tot[w2 * 64 + lane]; all += x; if (w2 < r) off += x; }
            float bt[4], kt[4], vt[4];
#pragma unroll
            for (int i = 0; i < 4; ++i) {
                const float rc = dir ? xr[4 - i] : xr[1 + i], rp = dir ? xr[3 - i] : xr[i], rn = dir ? xr[5 - i] : xr[2 + i];
                const float kc = dir ? xk[4 - i] : xk[1 + i], kp = dir ? xk[3 - i] : xk[i], kn = dir ? xk[5 - i] : xk[2 + i];
                const float vc = dir ? xv[4 - i] : xv[1 + i], vp = dir ? xv[3 - i] : xv[i], vn = dir ? xv[5 - i] : xv[2 + i];
                const float rr = rc + mpr * (rp - rc) + mnr * (rn - rc);
                const float k = kc + mpk * (kp - kc) + mnk * (kn - kc);
                const float v = vc + mpv * (vp - vc) + mnv * (vn - vc);
                const float av = bf2f(rawA[i]);
                const float cum = cl[i] + off;
                const float Pin = __expf(cum), Pprev = __expf(cum - Lv[i]), Pinv = __expf(-cum);
                const float kk = k * kkc * rawS[i];
                const float bb = kk * av * Pinv, kd = k * (1.0f + (av - 1.0f) * kac) * Pinv;
                const int tau = 4 * r + i;
                At[tau * 72 + lane] = (bf16_t)f2bf(-kk * Pprev); Rt[tau * 72 + lane] = (bf16_t)f2bf(rr * Pin); Bs[tau * 72 + lane] = (bf16_t)f2bf(bb); Ks[tau * 72 + lane] = (bf16_t)f2bf(kd);
                bt[i] = bb; kt[i] = kd; vt[i] = v;
            }
            { u32x2 w; w.x = pk2(bt[0], bt[1]); w.y = pk2(bt[2], bt[3]); *(LAS u32x2*)(BT + lane * 24 + 4 * r) = w; }
            { u32x2 w; w.x = pk2(kt[0], kt[1]); w.y = pk2(kt[2], kt[3]); *(LAS u32x2*)(KT + lane * 24 + 4 * r) = w; }
            { u32x2 w; w.x = pk2(vt[0], vt[1]); w.y = pk2(vt[2], vt[3]); *(LAS u32x2*)(VT + lane * 24 + 4 * r) = w; }
            if (r == 0) Pc[lane] = __expf(all);
            if (b + 1 < nb) SC2_LOAD(b + 1);
            BAR_LDS();
            {
                const LAS bf16_t* As = (mid & 1) ? Ks : Bs; const LAS bf16_t* Bsrc = (mid < 2) ? At : Rt;
                f32x4 m = (f32x4){0.f, 0.f, 0.f, 0.f};
#pragma unroll
                for (int ks = 0; ks < 2; ++ks) { const bf16x8 af = *(const LAS bf16x8*)(As + fr * 72 + 32 * ks + 8 * fq), bfv = *(const LAS bf16x8*)(Bsrc + fr * 72 + 32 * ks + 8 * fq); m = __builtin_amdgcn_mfma_f32_16x16x32_bf16(af, bfv, m, 0, 0, 0); }
#pragma unroll
                for (int i = 0; i < 4; ++i) { const int s = 4 * fq + i; const bool keep = (s < fr) || (mid >= 2 && s == fr); m[i] = keep ? m[i] : 0.f; }
                if (mid == 0) {
#pragma unroll
                    for (int i = 0; i < 4; ++i) Nf[(4 * fq + i) * 20 + fr] = m[i];
                }
                else { u32x2 w; w.x = pk2(m[0], m[1]); w.y = pk2(m[2], m[3]); LAS bf16_t* dst = mid == 1 ? MkaT : (mid == 2 ? MbrT : MkrT); *(LAS u32x2*)(dst + fr * 24 + 4 * fq) = w; }
            }
            if (b + 1 < nb) { LAS float* totn = (LAS float*)(gl0 + ((b + 1) & 1) * 28672 + 24576 - 1024);
                totn[r * 64 + lane] = (bf2f(rawL[0]) + bf2f(rawL[1])) + (bf2f(rawL[2]) + bf2f(rawL[3])); }
            if (mid == 0) {
                float acc[16];
#pragma unroll
                for (int tp = 0; tp < 16; ++tp) acc[tp] = (fr == tp) ? 1.0f : 0.f;
#pragma unroll
                for (int s2 = 0; s2 < 15; ++s2) {
                    const float ts = acc[s2];
#pragma unroll
                    for (int q = 0; q < 4; ++q) {
                        if (4 * q + 3 > s2) {
                            const f32x4 n4 = *(const LAS f32x4*)(Nf + s2 * 20 + 4 * q);
                            if (4 * q + 0 > s2) acc[4 * q + 0] += ts * n4.x;
                            if (4 * q + 1 > s2) acc[4 * q + 1] += ts * n4.y;
                            if (4 * q + 2 > s2) acc[4 * q + 2] += ts * n4.z;
                            if (4 * q + 3 > s2) acc[4 * q + 3] += ts * n4.w;
                        }
                    }
                }
                if (fq == 0) {
#pragma unroll
                    for (int tp = 0; tp < 16; ++tp) TTf[tp * 20 + fr] = acc[tp];
                }
            }
            BAR_LDS();
            const u32x2 z2 = (u32x2){0u, 0u};
            bf16x8 sb[2];
#pragma unroll
            for (int kb = 0; kb < 2; ++kb) { u32x4 w; w.x = pk2(accS[2 * kb][0], accS[2 * kb][1]); w.y = pk2(accS[2 * kb][2], accS[2 * kb][3]); w.z = pk2(accS[2 * kb + 1][0], accS[2 * kb + 1][1]); w.w = pk2(accS[2 * kb + 1][2], accS[2 * kb + 1][3]); sb[kb] = __builtin_bit_cast(bf16x8, w); }
            const u32x2 vlo = *(const LAS u32x2*)(VT + (16 * r + fr) * 24 + 4 * fq);
            f32x4 accX = (f32x4){0.f, 0.f, 0.f, 0.f}, accY = (f32x4){0.f, 0.f, 0.f, 0.f};
#pragma unroll
            for (int kb = 0; kb < 2; ++kb) { const u32x2 lo = *(const LAS u32x2*)(At + fr * 72 + 32 * kb + 4 * fq), hi = *(const LAS u32x2*)(At + fr * 72 + 32 * kb + 16 + 4 * fq); accX = __builtin_amdgcn_mfma_f32_16x16x32_bf16(mk8(lo, hi), sb[kb], accX, 0, 0, 0); }
            { const u32x2 alo = *(const LAS u32x2*)(MkaT + fr * 24 + 4 * fq); accX = __builtin_amdgcn_mfma_f32_16x16x32_bf16(mk8(alo, z2), mk8(vlo, z2), accX, 0, 0, 0); }
#pragma unroll
            for (int kb = 0; kb < 2; ++kb) { const u32x2 lo = *(const LAS u32x2*)(Rt + fr * 72 + 32 * kb + 4 * fq), hi = *(const LAS u32x2*)(Rt + fr * 72 + 32 * kb + 16 + 4 * fq); accY = __builtin_amdgcn_mfma_f32_16x16x32_bf16(mk8(lo, hi), sb[kb], accY, 0, 0, 0); }
            {
                f32x4 accSA = (f32x4){0.f, 0.f, 0.f, 0.f};
#pragma unroll
                for (int kk = 0; kk < 4; ++kk) accSA = __builtin_amdgcn_mfma_f32_16x16x4f32(TTf[fr * 20 + 4 * fq + kk], accX[kk], accSA, 0, 0, 0);
                u32x2 sav; sav.x = pk2(accSA[0], accSA[1]); sav.y = pk2(accSA[2], accSA[3]);
                const bf16x8 bsv = mk8(sav, vlo);
                { const u32x2 lo = *(const LAS u32x2*)(MbrT + fr * 24 + 4 * fq), hi = *(const LAS u32x2*)(MkrT + fr * 24 + 4 * fq); accY = __builtin_amdgcn_mfma_f32_16x16x32_bf16(mk8(lo, hi), bsv, accY, 0, 0, 0); }
#pragma unroll
                for (int i = 0; i < 4; ++i) { const int tau = b * 16 + 4 * fq + i; const int t = dir ? len - 1 - tau : tau; Y[(size_t)(row0 + t) * 512 + h * 64 + 16 * r + fr] = (bf16_t)f2bf(accY[i]); }
#pragma unroll
                for (int jt = 0; jt < 4; ++jt) {
                    const u32x2 lo = *(const LAS u32x2*)(BT + (16 * jt + fr) * 24 + 4 * fq), hi = *(const LAS u32x2*)(KT + (16 * jt + fr) * 24 + 4 * fq);
                    accS[jt] = __builtin_amdgcn_mfma_f32_16x16x32_bf16(mk8(lo, hi), bsv, accS[jt], 0, 0, 0);
                    const f32x4 pc4 = *(const LAS f32x4*)(Pc + 16 * jt + 4 * fq);
                    accS[jt] = accS[jt] * pc4;
                }
            }
        }
        BAR_LDS();
#undef SC2_LOAD
    }
}

__device__ __forceinline__ void gla_phase(KA a, LAS unsigned char* lds, int G, const int tid, const int bid) {
    const int wid = __builtin_amdgcn_readfirstlane(tid >> 6), lane = tid & 63, fr = lane & 15, fq = lane >> 4;
    unsigned char* ws = AWS;
    const bf16_t* PROJ = (const bf16_t*)(ws + WS_PROJ); bf16_t* MIX = (bf16_t*)(ws + WS_MIXED);
    constexpr int SD = 72;
    LAS bf16_t* Qin = (LAS bf16_t*)lds; LAS bf16_t* Kin = Qin + 64 * SD; LAS bf16_t* KdT = Kin + 64 * SD; LAS bf16_t* VT = KdT + 64 * SD; LAS bf16_t* STt = VT + 128 * SD;
    LAS float* tot = (LAS float*)(STt + 128 * SD); LAS float* bl = tot + 8 * 64;
    const int tt = wid & 3, eh = wid >> 2, dt = wid & 3, etg = (wid >> 2) * 4;
    const int gj = bid - 160;
    for (int ui = 0; ui < 2; ++ui) {
        const int u = 2 * gj + ui;
        int row0, len, h, dir;
        if (u < 128) { row0 = TP + (u >> 3) * 4096; len = 4096; h = (u >> 1) & 3; dir = u & 1; } else { const int v = u - 128; row0 = (v >> 3) * 2048; len = 2048; h = (v >> 1) & 3; dir = v & 1; }
        const int nch = len / 64;
        const int dtile = wid & 3, th = wid >> 2, d0 = 16 * dtile;
        u32x2 gb2;
        { const float* g2 = AIN(dir ? I_GK2_B : I_GK2_F) + h * 64 + d0 + fr; gb2.x = pk2(g2[(4 * fq) * 256], g2[(4 * fq + 1) * 256]); gb2.y = pk2(g2[(4 * fq + 2) * 256], g2[(4 * fq + 3) * 256]); }
        const float gkb = AIN(dir ? I_GKB_B : I_GKB_F)[h * 64 + d0 + fr];
        f32x4 accS[4];
#pragma unroll
        for (int e4 = 0; e4 < 4; ++e4) accS[e4] = (f32x4){0.f, 0.f, 0.f, 0.f};
        BAR_LDS();
        for (int i = tid; i < 128 * SD / 2; i += 512) ((LAS unsigned*)STt)[i] = 0u;
        unsigned qraw[8], kraw[8], vraw[16]; u32x2 graw[2];
        const unsigned qoff = (unsigned)((32 * th + 4 * fq) * PROJ_LD + h * 64 + d0 + fr);
        const unsigned voff = (unsigned)((8 * wid) * PROJ_LD + 512 + h * 128 + lane);
        const unsigned goff = (unsigned)((32 * th + fr) * PROJ_LD + 1024 + 4 * fq);
#define GLA_LOAD(n_) do { const bf16_t* Pc = PROJ + (size_t)(row0 + (n_) * 64) * PROJ_LD + 1952; \
        _Pragma("unroll") for (int tti = 0; tti < 2; ++tti) { _Pragma("unroll") for (int i = 0; i < 4; ++i) { const unsigned o = qoff + (unsigned)((16 * tti + i) * PROJ_LD); qraw[4 * tti + i] = Pc[o]; kraw[4 * tti + i] = Pc[o + 256]; } \
            graw[tti] = *(const u32x2*)(Pc + goff + (unsigned)(16 * tti * PROJ_LD)); } \
        _Pragma("unroll") for (int i = 0; i < 8; ++i) { const unsigned o = voff + (unsigned)(i * PROJ_LD); vraw[i] = Pc[o]; vraw[8 + i] = Pc[o + 64]; } } while (0)
        GLA_LOAD(dir ? nch - 1 : 0);
        for (int ci = 0; ci < nch; ++ci) {
            const int n = dir ? nch - 1 - ci : ci; const int crow = row0 + n * 64;
            const u32x2 z2 = (u32x2){0u, 0u};
            float lg[2][4], pre[2][4];
            float run = 0.f;
#pragma unroll
            for (int tti = 0; tti < 2; ++tti) {
                const f32x4 z4 = __builtin_amdgcn_mfma_f32_16x16x32_bf16(mk8(graw[tti], z2), mk8(gb2, z2), (f32x4){0.f, 0.f, 0.f, 0.f}, 0, 0, 0);
#pragma unroll
                for (int i = 0; i < 4; ++i) { const float z = z4[i] + gkb; const float az = fabsf(z); lg[tti][i] = ((z < 0.f ? z : 0.f) - __logf(1.0f + __expf(-az))) * (1.0f / 16.0f); }
                float c0 = lg[tti][0], c1 = c0 + lg[tti][1], c2 = c1 + lg[tti][2], c3 = c2 + lg[tti][3];
                float x = c3;
                { const float y = __shfl_up(x, 16); if (fq >= 1) x += y; }
                { const float y = __shfl_up(x, 32); if (fq >= 2) x += y; }
                const float excl = x - c3 + run;
                pre[tti][0] = c0 + excl; pre[tti][1] = c1 + excl; pre[tti][2] = c2 + excl; pre[tti][3] = c3 + excl;
                run += __shfl(x, 48 + fr);
            }
            if (fq == 0) tot[th * 64 + d0 + fr] = run;
            BAR_LDS();
            const float t0s = tot[d0 + fr], t1s = tot[64 + d0 + fr];
            const float all = t0s + t1s, offp = th ? t0s : 0.f;
            const float eall = __expf(all);
#pragma unroll
            for (int tti = 0; tti < 2; ++tti) {
                float kd[4];
#pragma unroll
                for (int i = 0; i < 4; ++i) {
                    const float pin = pre[tti][i] + offp;
                    const float bb = dir ? (all - pin + lg[tti][i]) : pin;
                    const float q = bf2f(qraw[4 * tti + i]) * 0.125f, k = bf2f(kraw[4 * tti + i]);
                    const float eb = __expf(bb), ieb = __builtin_amdgcn_rcpf(eb);
                    const int t = 32 * th + 16 * tti + 4 * fq + i;
                    Qin[t * SD + d0 + fr] = (bf16_t)f2bf(q * eb);
                    const float kin = k * ieb;
                    Kin[t * SD + d0 + fr] = (bf16_t)f2bf(kin);
                    kd[i] = kin * eall;
                }
                u32x2 w; w.x = pk2(kd[0], kd[1]); w.y = pk2(kd[2], kd[3]); *(LAS u32x2*)(KdT + (d0 + fr) * SD + 32 * th + 16 * tti + 4 * fq) = w;
            }
            { u32x4 w; w.x = vraw[0] | (vraw[1] << 16); w.y = vraw[2] | (vraw[3] << 16); w.z = vraw[4] | (vraw[5] << 16); w.w = vraw[6] | (vraw[7] << 16); *(LAS u32x4*)(VT + lane * SD + 8 * wid) = w; }
            { u32x4 w; w.x = vraw[8] | (vraw[9] << 16); w.y = vraw[10] | (vraw[11] << 16); w.z = vraw[12] | (vraw[13] << 16); w.w = vraw[14] | (vraw[15] << 16); *(LAS u32x4*)(VT + (64 + lane) * SD + 8 * wid) = w; }
            if (th == 0 && fq == 0) bl[d0 + fr] = eall;
            { const int cn = ci + 1 < nch ? ci + 1 : ci; GLA_LOAD(dir ? nch - 1 - cn : cn); }
            BAR_LDS();
            bf16x8 qf[2];
#pragma unroll
            for (int ks = 0; ks < 2; ++ks) qf[ks] = *(const LAS bf16x8*)(Qin + (16 * tt + fr) * SD + 32 * ks + 8 * fq);
            f32x4 accA[4];
#pragma unroll
            for (int st = 0; st < 4; ++st) { accA[st] = (f32x4){0.f, 0.f, 0.f, 0.f};
#pragma unroll
                for (int ks = 0; ks < 2; ++ks) { const bf16x8 kf = *(const LAS bf16x8*)(Kin + (16 * st + fr) * SD + 32 * ks + 8 * fq); accA[st] = __builtin_amdgcn_mfma_f32_16x16x32_bf16(kf, qf[ks], accA[st], 0, 0, 0); } }
            const int tq = 16 * tt + fr;
#pragma unroll
            for (int st = 0; st < 4; ++st)
#pragma unroll
                for (int i = 0; i < 4; ++i) { const int s = 16 * st + 4 * fq + i; const bool keep = dir ? (s >= tq) : (s <= tq); accA[st][i] = keep ? accA[st][i] : 0.f; }
            bf16x8 pf[2];
#pragma unroll
            for (int kb = 0; kb < 2; ++kb) { u32x4 w; w.x = pk2(accA[2 * kb][0], accA[2 * kb][1]); w.y = pk2(accA[2 * kb][2], accA[2 * kb][3]); w.z = pk2(accA[2 * kb + 1][0], accA[2 * kb + 1][1]); w.w = pk2(accA[2 * kb + 1][2], accA[2 * kb + 1][3]); pf[kb] = __builtin_bit_cast(bf16x8, w); }
            f32x4 accO[4];
#pragma unroll
            for (int et = 0; et < 4; ++et) {
                accO[et] = (f32x4){0.f, 0.f, 0.f, 0.f};
                const int E = eh * 64 + 16 * et;
#pragma unroll
                for (int kb = 0; kb < 2; ++kb) {
                    const u32x2 lo = *(const LAS u32x2*)(VT + (E + fr) * SD + 32 * kb + 4 * fq), hi = *(const LAS u32x2*)(VT + (E + fr) * SD + 32 * kb + 16 + 4 * fq);
                    accO[et] = __builtin_amdgcn_mfma_f32_16x16x32_bf16(mk8(lo, hi), pf[kb], accO[et], 0, 0, 0);
                }
#pragma unroll
                for (int ks = 0; ks < 2; ++ks) { const bf16x8 sf = *(const LAS bf16x8*)(STt + (E + fr) * SD + 32 * ks + 8 * fq); accO[et] = __builtin_amdgcn_mfma_f32_16x16x32_bf16(sf, qf[ks], accO[et], 0, 0, 0); }
            }
            const f32x4 dec = *(const LAS f32x4*)(bl + 16 * dt + 4 * fq);
#pragma unroll
            for (int e4 = 0; e4 < 4; ++e4) {
                accS[e4] = accS[e4] * dec;
                const int Et = (etg + e4) * 16;
#pragma unroll
                for (int kb = 0; kb < 2; ++kb) {
                    const bf16x8 kdf = *(const LAS bf16x8*)(KdT + (16 * dt + fr) * SD + 32 * kb + 8 * fq);
                    const bf16x8 vf = *(const LAS bf16x8*)(VT + (Et + fr) * SD + 32 * kb + 8 * fq);
                    accS[e4] = __builtin_amdgcn_mfma_f32_16x16x32_bf16(kdf, vf, accS[e4], 0, 0, 0);
                }
            }
            bf16_t* orow = MIX + (size_t)(crow + tq) * 1024 + 512 + h * 128 + eh * 64 + 4 * fq;
            if (dir == 1) {
#pragma unroll
                for (int et = 0; et < 4; ++et) { const u32x2 w = *(const u32x2*)(orow + 16 * et); accO[et][0] += bflo(w.x); accO[et][1] += bfhi(w.x); accO[et][2] += bflo(w.y); accO[et][3] += bfhi(w.y); }
            }
#pragma unroll
            for (int et = 0; et < 4; ++et) { u32x2 w; w.x = pk2(accO[et][0], accO[et][1]); w.y = pk2(accO[et][2], accO[et][3]); *(u32x2*)(orow + 16 * et) = w; }
            BAR_LDS();
#pragma unroll
            for (int e4 = 0; e4 < 4; ++e4) { u32x2 w; w.x = pk2(accS[e4][0], accS[e4][1]); w.y = pk2(accS[e4][2], accS[e4][3]); *(LAS u32x2*)(STt + ((etg + e4) * 16 + fr) * SD + 16 * dt + 4 * fq) = w; }
        }
#undef GLA_LOAD
    }
}

__device__ __forceinline__ void combine_phase(KA a, int G, const int tid, const int bid) {
    const int wid = tid >> 6, lane = tid & 63;
    unsigned char* ws = AWS;
    const bf16_t* PROJ = (const bf16_t*)(ws + WS_PROJ); const bf16_t* LO = (const bf16_t*)AOUT; const bf16_t* YF = (const bf16_t*)(ws + WS_YF); const bf16_t* YB = (const bf16_t*)(ws + WS_YB);
    const bf16_t* GB = (const bf16_t*)(ws + WS_GB); bf16_t* MIX = (bf16_t*)(ws + WS_MIXED);
    const int gw = bid * 8 + wid, NGW = G * 8;
    const int c0 = 8 * lane;
    float mpr[8], mnr[8], mpk[8], mnk[8], mpv[8], mnv[8], kav[8], rkv[8], lw[8], lb[8];
    ldf8(AIN(I_MU_PREV) + c0, mpr); ldf8(AIN(I_MU_NEXT) + c0, mnr); ldf8(AIN(I_MU_PREV) + 512 + c0, mpk); ldf8(AIN(I_MU_NEXT) + 512 + c0, mnk);
    ldf8(AIN(I_MU_PREV) + 1024 + c0, mpv); ldf8(AIN(I_MU_NEXT) + 1024 + c0, mnv); ldf8(AIN(I_K_A) + c0, kav); ldf8(AIN(I_R_K) + c0, rkv); ldf8(AIN(I_LNX_W) + c0, lw); ldf8(AIN(I_LNX_B) + c0, lb);
    float gnw[8]; ldf8(AIN(I_GLA_NW) + (c0 & 127), gnw);
    for (int t = gw; t < T_ALL; t += NGW) {
        int pos, len; seq_pos(t, pos, len); const bool first = pos == 0, last = pos == len - 1;
        const bf16_t* P = PROJ + (size_t)t * PROJ_LD;
        float r[8], k[8], v[8], af[8], ab[8], yf[8], yb[8], g[8];
        shift8(P, c0, first, last, mpr, mnr, r); shift8(P, 512 + c0, first, last, mpk, mnk, k); shift8(P, 1024 + c0, first, last, mpv, mnv, v);
        ld8nt(LO + (size_t)t * 2048 + 1024 + c0, af); ld8nt(LO + (size_t)t * 2048 + 1536 + c0, ab);
        ld8nt(YF + (size_t)t * 512 + c0, yf); ld8nt(YB + (size_t)t * 512 + c0, yb); ld8nt(GB + (size_t)t * 512 + c0, g);
        float bon = 0.f, sy = 0.f;
#pragma unroll
        for (int j = 0; j < 8; ++j) { bon += r[j] * k[j] * (2.0f + (af[j] + ab[j] - 2.0f) * kav[j]) * rkv[j]; yf[j] += yb[j]; sy += yf[j]; }
        bon += __shfl_xor(bon, 1); sy += __shfl_xor(sy, 1); bon += __shfl_xor(bon, 2); sy += __shfl_xor(sy, 2); bon += __shfl_xor(bon, 4); sy += __shfl_xor(sy, 4);
        const float mean = sy * (1.0f / 64.0f);
        float sv = 0.f;
#pragma unroll
        for (int j = 0; j < 8; ++j) { yf[j] -= mean; sv += yf[j] * yf[j]; }
        sv += __shfl_xor(sv, 1); sv += __shfl_xor(sv, 2); sv += __shfl_xor(sv, 4);
        const float rstd = 1.0f / sqrtf(sv * (1.0f / 64.0f) + 64e-5f);
        float o[8];
#pragma unroll
        for (int j = 0; j < 8; ++j) o[j] = (yf[j] * rstd * lw[j] + lb[j] + bon * v[j]) * g[j];
        *(u32x4*)(MIX + (size_t)t * 1024 + c0) = st8(o);
        float of[8], gg[8];
        ld8nt(MIX + (size_t)t * 1024 + 512 + c0, of); ld8nt(P + 1952 + 1040 + c0, gg);
        float ss = 0.f;
#pragma unroll
        for (int j = 0; j < 8; ++j) ss += of[j] * of[j];
        ss += __shfl_xor(ss, 1); ss += __shfl_xor(ss, 2); ss += __shfl_xor(ss, 4); ss += __shfl_xor(ss, 8);
        const float rsg = 1.0f / sqrtf(ss * (1.0f / 128.0f) + 1e-5f);
#pragma unroll
        for (int j = 0; j < 8; ++j) o[j] = of[j] * rsg * gnw[j] * gg[j] * sigmoidf_(gg[j]);
        *(u32x4*)(MIX + (size_t)t * 1024 + 512 + c0) = st8(o);
    }
}

__device__ __forceinline__ void rowpass_phase(KA a, int G, int which, const int tid, const int bid) {
    const int wid = tid >> 6, lane = tid & 63;
    unsigned char* ws = AWS; float* sm = (float*)(ws + WS_SMALL);
    bf16_t* XBUF = (bf16_t*)(ws + WS_MO);
    const float* ssq = sm + (which == 0 ? OFF_SSQ1 : (which == 1 ? OFF_SSQ2 : OFF_SSQ3));
    const float* gp = AIN(which == 0 ? I_G_MIX_POST : (which == 1 ? I_G_X_POST : I_G_FFN_POST));
    float* rsout = sm + (which == 0 ? OFF_RS1 : OFF_RS2);
    const int gw = bid * 8 + wid, NGW = G * 8;
    f32x4 gv[4];
#pragma unroll
    for (int j = 0; j < 4; ++j) gv[j] = ((const f32x4*)gp)[lane + 64 * j];
    constexpr int NR = 3;
    for (int t0 = gw; t0 < T_ALL; t0 += NR * NGW) {
        int tt[NR]; float sc[NR]; f32x4 bvf[NR][4]; u32x2 bvh[NR][4], brw[NR][4];
#pragma unroll
        for (int q = 0; q < NR; ++q) {
            const int t = t0 + q * NGW < T_ALL ? t0 + q * NGW : t0; tt[q] = t;
            const bf16_t* BRp = which == 0 ? (const bf16_t*)(ws + WS_MO) + (size_t)t * DM : (which == 1 ? (const bf16_t*)(ws + WS_XO) + (size_t)t * DM
                              : (t < FO_SPLIT ? (const bf16_t*)(ws + WS_KB) + (size_t)t * DM : (const bf16_t*)(ws + WS_FO_HI) + (size_t)(t - FO_SPLIT) * DM));
            const u32x2* br = (const u32x2*)BRp + lane;
            const u32x2* xb = (const u32x2*)(XBUF + (size_t)t * DM) + lane;
            const f32x4* basef = (const f32x4*)xrow_ptr(a, t) + lane;
#pragma unroll
            for (int j = 0; j < 4; ++j) { if (which == 0) bvf[q][j] = __builtin_nontemporal_load(basef + 64 * j); else bvh[q][j] = __builtin_nontemporal_load(xb + 64 * j); brw[q][j] = __builtin_nontemporal_load(br + 64 * j); }
            sc[q] = ssq[t];
        }
#pragma unroll
        for (int q = 0; q < NR; ++q) {
            if (q > 0 && tt[q] == t0) continue;
            const int t = tt[q];
            const float scl = 1.0f / sqrtf(sc[q] * (1.0f / DM) + 1e-6f);
            u32x2* xb = (u32x2*)(XBUF + (size_t)t * DM) + lane;
            f32x4* orow = (f32x4*)(AOUT + (size_t)t * DM) + lane;
            f32x4 x[4]; float s = 0.f;
#pragma unroll
            for (int j = 0; j < 4; ++j) {
                f32x4 bv;
                if (which == 0) bv = bvf[q][j]; else { const u32x2 w1 = bvh[q][j]; bv = (f32x4){bflo(w1.x), bfhi(w1.x), bflo(w1.y), bfhi(w1.y)}; }
                const u32x2 w = brw[q][j];
                x[j].x = bv.x + bflo(w.x) * scl * gv[j].x; x[j].y = bv.y + bfhi(w.x) * scl * gv[j].y; x[j].z = bv.z + bflo(w.y) * scl * gv[j].z; x[j].w = bv.w + bfhi(w.y) * scl * gv[j].w;
                s += (x[j].x * x[j].x + x[j].y * x[j].y) + (x[j].z * x[j].z + x[j].w * x[j].w);
            }
            if (which == 2) {
#pragma unroll
                for (int j = 0; j < 4; ++j) __builtin_nontemporal_store(x[j], orow + 64 * j);
            } else {
                s = wave_sum(s);
#pragma unroll
                for (int j = 0; j < 4; ++j) { u32x2 w; w.x = pk2(x[j].x, x[j].y); w.y = pk2(x[j].z, x[j].w); xb[64 * j] = w; }
                if (lane == 0) rsout[t] = 1.0f / sqrtf(s * (1.0f / DM) + 1e-6f);
            }
        }
    }
}

__device__ __forceinline__ void xattn_phase(KA a, LAS unsigned char* lds, int G, const int tid, const int bid) {
    const int wid = __builtin_amdgcn_readfirstlane(tid >> 6), lane = tid & 63, fr = lane & 15, fq = lane >> 4;
    unsigned char* ws = AWS;
    const bf16_t* Q = (const bf16_t*)(ws + WS_Q); const bf16_t* KB = (const bf16_t*)(ws + WS_KB); const bf16_t* VTg = (const bf16_t*)(ws + WS_VT); bf16_t* OB = (bf16_t*)(ws + WS_OB);
    constexpr int KS = 264, VS = 68;
    LAS bf16_t* Ks = (LAS bf16_t*)lds;
    LAS bf16_t* Vs = Ks + 64 * KS;
    u32x4 stg[4];
#define XA_FETCH(u_, s_) do { const int qt_ = (u_) >> 2, h_ = (u_) & 3, r0_ = qt_ * 128; const int bi_ = r0_ < TP ? r0_ / 2048 : 8 + (r0_ - TP) / 4096; \
        if ((s_) < 4) { _Pragma("unroll") for (int i = 0; i < 4; ++i) { const int cidx = tid + 512 * i, r = cidx >> 5, c8 = cidx & 31; stg[i] = *(const u32x4*)(KB + (size_t)(bi_ * 256 + (s_) * 64 + r) * 1024 + h_ * 256 + c8 * 8); } } \
        else { _Pragma("unroll") for (int i = 0; i < 4; ++i) { const int cidx = tid + 512 * i, r = cidx >> 3, c8 = cidx & 7; stg[i] = *(const u32x4*)(VTg + (size_t)(h_ * 256 + r) * TM + bi_ * 256 + ((s_) - 4) * 64 + c8 * 8); } } } while (0)
#define XA_PUT_K() do { _Pragma("unroll") for (int i = 0; i < 4; ++i) { const int cidx = tid + 512 * i, r = cidx >> 5, c8 = cidx & 31; *(LAS u32x4*)(Ks + r * KS + c8 * 8) = stg[i]; } } while (0)
#define XA_PUT_V() do { _Pragma("unroll") for (int i = 0; i < 4; ++i) { const int cidx = tid + 512 * i, r = cidx >> 3, c8 = cidx & 7; *(LAS u32x2*)(Vs + r * VS + c8 * 8) = (u32x2){stg[i].x, stg[i].y}; *(LAS u32x2*)(Vs + r * VS + c8 * 8 + 4) = (u32x2){stg[i].z, stg[i].w}; } } while (0)
    if (bid < 2560) XA_FETCH(bid, 0);
    for (int u = bid; u < 2560; u += G) {
        const int qt = u >> 2, h = u & 3, row0 = qt * 128;
        const int qrow = row0 + 16 * wid + fr;
        bf16x8 qf[8];
#pragma unroll
        for (int ks = 0; ks < 8; ++ks) qf[ks] = __builtin_nontemporal_load((const bf16x8*)(Q + (size_t)qrow * 1024 + h * 256 + 32 * ks + 8 * fq));
        f32x4 accS[16];
#pragma unroll
        for (int n = 0; n < 16; ++n) accS[n] = (f32x4){0.f, 0.f, 0.f, 0.f};
#pragma unroll
        for (int kt = 0; kt < 4; ++kt) {
            BAR_LDS();
            XA_PUT_K();
            XA_FETCH(u, kt + 1);
            BAR_LDS();
#pragma unroll
            for (int n = 0; n < 4; ++n)
#pragma unroll
                for (int ks = 0; ks < 8; ++ks) { const bf16x8 kf = *(const LAS bf16x8*)(Ks + (16 * n + fr) * KS + 32 * ks + 8 * fq); accS[kt * 4 + n] = __builtin_amdgcn_mfma_f32_16x16x32_bf16(kf, qf[ks], accS[kt * 4 + n], 0, 0, 0); }
        }
        float mx = -3.0e38f;
#pragma unroll
        for (int n = 0; n < 16; ++n)
#pragma unroll
            for (int i = 0; i < 4; ++i) mx = fmaxf(mx, accS[n][i]);
        mx = fmaxf(mx, __shfl_xor(mx, 16)); mx = fmaxf(mx, __shfl_xor(mx, 32));
        float sum = 0.f;
#pragma unroll
        for (int n = 0; n < 16; ++n)
#pragma unroll
            for (int i = 0; i < 4; ++i) { const float p = __expf(accS[n][i] - mx); accS[n][i] = p; sum += p; }
        sum += __shfl_xor(sum, 16); sum += __shfl_xor(sum, 32);
        const float inv = 1.0f / sum;
        bf16x8 pf[8];
#pragma unroll
        for (int kb = 0; kb < 8; ++kb) { u32x4 w; w.x = pk2(accS[2 * kb][0], accS[2 * kb][1]); w.y = pk2(accS[2 * kb][2], accS[2 * kb][3]); w.z = pk2(accS[2 * kb + 1][0], accS[2 * kb + 1][1]); w.w = pk2(accS[2 * kb + 1][2], accS[2 * kb + 1][3]); pf[kb] = __builtin_bit_cast(bf16x8, w); }
        f32x4 accO[16];
#pragma unroll
        for (int n = 0; n < 16; ++n) accO[n] = (f32x4){0.f, 0.f, 0.f, 0.f};
        const int un = u + G;
#pragma unroll
        for (int k4 = 0; k4 < 4; ++k4) {
            BAR_LDS();
            XA_PUT_V();
            if (k4 < 3) XA_FETCH(u, 5 + k4); else if (un < 2560) XA_FETCH(un, 0);
            BAR_LDS();
#pragma unroll
            for (int kb = 0; kb < 2; ++kb)
#pragma unroll
                for (int dtile = 0; dtile < 16; ++dtile) {
                    const u32x2 lo = *(const LAS u32x2*)(Vs + (16 * dtile + fr) * VS + 32 * kb + 4 * fq), hi = *(const LAS u32x2*)(Vs + (16 * dtile + fr) * VS + 32 * kb + 16 + 4 * fq);
                    accO[dtile] = __builtin_amdgcn_mfma_f32_16x16x32_bf16(mk8(lo, hi), pf[k4 * 2 + kb], accO[dtile], 0, 0, 0);
                }
        }
        bf16_t* orow = OB + (size_t)qrow * 1024 + h * 256 + 4 * fq;
#pragma unroll
        for (int dtile = 0; dtile < 16; ++dtile) { u32x2 w; w.x = pk2(accO[dtile][0] * inv, accO[dtile][1] * inv); w.y = pk2(accO[dtile][2] * inv, accO[dtile][3] * inv); *(u32x2*)(orow + 16 * dtile) = w; }
    }
#undef XA_FETCH
#undef XA_PUT_K
#undef XA_PUT_V
}

#define XB_TMO      128
#define XB_XCNT(j)  (256  + 64 * (j))
#define XB_XSUB(j)  (1280 + 64 * (j))
#define XB_XGEN(j)  (2304 + 64 * (j))
#define XB_TOP      3328
#define XB_TOPGEN   3392
#define XB_SPIN_CAP (1u << 22)
__device__ __forceinline__ unsigned xb_ld(unsigned* p)              { return __hip_atomic_load(p, __ATOMIC_RELAXED, __HIP_MEMORY_SCOPE_AGENT); }
__device__ __forceinline__ unsigned xb_add(unsigned* p, unsigned v) { return __hip_atomic_fetch_add(p, v, __ATOMIC_RELAXED, __HIP_MEMORY_SCOPE_AGENT); }
__device__ __forceinline__ unsigned xb_xcc_id() { return (unsigned)__builtin_amdgcn_s_getreg((3 << 11) | 20) & 0xFu; }
#define XB_SPIN(cond, bar) do { unsigned _sp = 0; while (cond) { __builtin_amdgcn_s_sleep(1); \
    if ((++_sp & 255u) == 0u) { if (xb_ld(&(bar)[XB_TMO])) break; if (_sp > XB_SPIN_CAP) { atomicAdd(&(bar)[XB_TMO], 1u); break; } } } } while (0)
struct XcdBarrier { unsigned* bar; unsigned x; volatile LAS unsigned* st; };
__device__ __forceinline__ XcdBarrier xcd_barrier_post(unsigned* bar, volatile LAS unsigned* st, int tid) {
    XcdBarrier b; b.bar = bar; b.x = xb_xcc_id(); b.st = st;
    if (tid == 0) (void)xb_add(&bar[XB_XCNT(b.x)], 1u);
    return b;
}
__device__ __forceinline__ void xcd_barrier_complete(unsigned* bar, unsigned x, unsigned G, unsigned& nloc, unsigned& nx) {
    unsigned sum, cnt, mine, sp = 0u;
    for (;;) {
        sum = 0u; cnt = 0u; mine = 0u;
#pragma unroll
        for (unsigned j = 0; j < 16; ++j) { const unsigned c = xb_ld(&bar[XB_XCNT(j)]); sum += c; cnt += (c > 0u) ? 1u : 0u; mine = (j == x) ? c : mine; }
        if (sum == G) break;
        __builtin_amdgcn_s_sleep(1);
        if ((++sp & 255u) == 0u) { if (xb_ld(&bar[XB_TMO])) break; if (sp > XB_SPIN_CAP) { atomicAdd(&bar[XB_TMO], 1u); break; } }
    }
    nloc = mine > 0u ? mine : 1u; nx = cnt > 0u ? cnt : 1u;
}
__device__ __forceinline__ void xcd_barrier(const XcdBarrier& b, int tid, unsigned G) {
    asm volatile("s_waitcnt vmcnt(0)" ::: "memory");
    __syncthreads();
    if (tid == 0) {
        unsigned* bar = b.bar;
        __builtin_amdgcn_s_waitcnt(0);
        unsigned nloc = b.st[0], nx = b.st[1];
        if (nloc == 0u) { xcd_barrier_complete(bar, b.x, G, nloc, nx); b.st[0] = nloc; b.st[1] = nx; }
        const unsigned old = xb_add(&bar[XB_XSUB(b.x)], 1u);
        const unsigned gen = old / nloc;
        if (old + 1u == (gen + 1u) * nloc) {
            __builtin_amdgcn_fence(__ATOMIC_RELEASE, "agent");
            asm volatile("s_waitcnt vmcnt(0)" ::: "memory");
            const unsigned og = xb_add(&bar[XB_TOP], 1u);
            const unsigned tg = og / nx;
            if (og + 1u == (tg + 1u) * nx) xb_add(&bar[XB_TOPGEN], 1u);
            else XB_SPIN(xb_ld(&bar[XB_TOPGEN]) == tg, bar);
            __builtin_amdgcn_fence(__ATOMIC_ACQUIRE, "agent");
            xb_add(&bar[XB_XGEN(b.x)], 1u);
            asm volatile("s_waitcnt vmcnt(0)" ::: "memory");
        } else {
            XB_SPIN(xb_ld(&bar[XB_XGEN(b.x)]) == gen, bar);
            __builtin_amdgcn_fence(__ATOMIC_ACQUIRE, "agent");
            asm volatile("s_waitcnt vmcnt(0)" ::: "memory");
        }
    }
    __syncthreads();
}

__device__ __forceinline__ void build_gemm(KA a, int gi, pg8::Gemm& g) {
    unsigned char* ws = AWS;
    switch (gi) {
    case 0: g = pg8::Gemm{(const bf16_t*)(ws + WS_XB), (const bf16_t*)(ws + WS_WIN), T_ALL, 3584, 1024, 1024, 1024}; break;
    case 1: g = pg8::Gemm{(const bf16_t*)(ws + WS_MEMB), (const bf16_t*)(ws + WS_WKV), TM, 1024, 1024, 1024, 1024}; break;
    case 2: g = pg8::Gemm{(const bf16_t*)(ws + WS_WKV) + (size_t)1024 * 1024, (const bf16_t*)(ws + WS_MEMB), 1024, TM, 1024, 1024, 1024}; break;
    case 3: g = pg8::Gemm{(const bf16_t*)(ws + WS_AL), (const bf16_t*)(ws + WS_WL), T_ALL, 2048, 256, 512, 512}; break;
    case 9: g = pg8::Gemm{(const bf16_t*)(ws + WS_AL) + 256, (const bf16_t*)(ws + WS_WL) + (size_t)2048 * 512 + 256, T_ALL, 512, 256, 512, 512}; break;
    case 4: g = pg8::Gemm{(const bf16_t*)(ws + WS_MIXED), (const bf16_t*)(ws + WS_WOUT), T_ALL, 1024, 1024, 1024, 1024}; break;
    case 5: g = pg8::Gemm{(const bf16_t*)(ws + WS_MO), (const bf16_t*)(ws + WS_WQ), T_ALL, 1024, 1024, 1024, 1024}; break;
    case 6: g = pg8::Gemm{(const bf16_t*)(ws + WS_OB), (const bf16_t*)(ws + WS_WO), T_ALL, 1024, 1024, 1024, 1024}; break;
    case 7: g = pg8::Gemm{(const bf16_t*)(ws + WS_MO), (const bf16_t*)(ws + WS_W1), T_ALL, 4096, 1024, 1024, 1024}; break;
    default: g = pg8::Gemm{(const bf16_t*)(ws + WS_HID), (const bf16_t*)(ws + WS_W2), T_ALL, 1024, 4096, 4096, 4096}; break;
    }
}

__global__ void __launch_bounds__(512, 2) fwd_kernel(Args args_unused) {
    extern __shared__ __attribute__((aligned(16))) unsigned char lds_raw[];
    LAS unsigned char* lds = (LAS unsigned char*)lds_raw;
    cg::grid_group grid = cg::this_grid();
    KA a0 = (KA)__builtin_amdgcn_kernarg_segment_ptr();
    const int ph_lo = a0->ph_lo, ph_hi = a0->ph_hi;
    volatile LAS unsigned* xst = (volatile LAS unsigned*)(lds + 131072);
    if (threadIdx.x < 2) xst[threadIdx.x] = 0u;
    __syncthreads();
    unsigned* barw = (unsigned*)((unsigned char*)a0->ws);
    XcdBarrier xb; xb.bar = barw; xb.x = 0; xb.st = xst;
    for (int ph = ph_lo; ph < ph_hi; ++ph) {
        if (ph == 5 && SCAN_V == 2) continue;
        if (ph > ph_lo) {
            if (ph_lo == 0 && ph > 1) xcd_barrier(xb, threadIdx.x, gridDim.x);
            else { grid.sync(); if (ph_lo == 0) xb = xcd_barrier_post(barw, xst, threadIdx.x); }
        }
        KA a = (KA)__builtin_amdgcn_kernarg_segment_ptr();
        int tid = threadIdx.x, bid = blockIdx.x, G = gridDim.x;
        asm volatile("" : "+s"(a), "+v"(tid), "+s"(bid), "+s"(G));
        int g0 = 0, g1 = 0, gx = -1;
        switch (ph) {
        case 0: if (EN(0)) p0_phase(a, lds, G, tid, bid); if (DUP_PHASE == 0 || DUP_PHASE == 100) { __syncthreads(); p0_phase(a, lds, G, tid, bid); } break;
        case 1: g0 = 0; g1 = 3; break;
        case 2: if (EN(2)) p2_phase(a, G, tid, bid); if (DUP_PHASE == 2 || DUP_PHASE == 100) { __syncthreads(); p2_phase(a, G, tid, bid); } break;
        case 3: g0 = 3; g1 = 4; gx = 9; break;
        case 4: if (EN(4)) { if (SCAN_V == 1) scan_phase(a, lds, G, tid, bid); else if (bid < 160) scan2_phase(a, lds, G, tid, bid); else gla_phase(a, lds, G, tid, bid); }
                if (DUP_PHASE == 41 && bid < 160) { __syncthreads(); scan2_phase(a, lds, G, tid, bid); }
                if (DUP_PHASE == 42 && bid >= 160) { __syncthreads(); gla_phase(a, lds, G, tid, bid); } break;
        case 5: if (EN(5) && SCAN_V == 1) gla_phase(a, lds, G, tid, bid); break;
        case 6: if (EN(6)) combine_phase(a, G, tid, bid); if (DUP_PHASE == 6 || DUP_PHASE == 100) { __syncthreads(); combine_phase(a, G, tid, bid); } break;
        case 7: g0 = 4; g1 = 5; break;
        case 8: if (EN(8)) rowpass_phase(a, G, 0, tid, bid); break;
        case 9: g0 = 5; g1 = 6; break;
        case 10: if (EN(10)) xattn_phase(a, lds, G, tid, bid); if (DUP_PHASE == 10) { __syncthreads(); xattn_phase(a, lds, G, tid, bid); } break;
        case 11: g0 = 6; g1 = 7; break;
        case 12: if (EN(8)) rowpass_phase(a, G, 1, tid, bid); break;
        case 13: g0 = 7; g1 = 8; break;
        case 14: g0 = 8; g1 = 9; break;
        default: if (EN(8)) rowpass_phase(a, G, 2, tid, bid); if (DUP_PHASE == 15) { __syncthreads(); rowpass_phase(a, G, 2, tid, bid); } break;
        }
        if (EN(1)) for (int rep = 0; rep < ((DUP_PHASE == ph && g1 > g0) ? 2 : 1); ++rep) for (int gq = g0; gq < g1 + (gx >= 0 ? 1 : 0); ++gq) {
            const int gi = gq < g1 ? gq : gx;
            pg8::Gemm g; build_gemm(a, gi, g); pg8::EpiD E{gi};
            pg8::StaticOrder S; S.init(g.M, g.N, G, (gi == 1 || gi == 2) ? (G - 1 - bid) : bid);
            __syncthreads();
            pg8::gemm_phase(lds, g, S, E, tid);
        }
    }
}

extern "C" void kernel_launch(void* const* d_in, const int* in_sizes, int n_in, void* d_out, int out_size, void* d_ws, size_t ws_size, hipStream_t stream) {
    static int grid = 0;
    if (grid == 0) {
        int dev = 0, cus = 0, per_cu = 0;
        (void)hipGetDevice(&dev);
        (void)hipDeviceGetAttribute(&cus, hipDeviceAttributeMultiprocessorCount, dev);
        if (hipFuncSetAttribute((const void*)fwd_kernel, hipFuncAttributeMaxDynamicSharedMemorySize, LDS_BYTES) != hipSuccess) { fprintf(stderr, "hipFuncSetAttribute failed\n"); }
        if (hipOccupancyMaxActiveBlocksPerMultiprocessor(&per_cu, (const void*)fwd_kernel, 512, LDS_BYTES) != hipSuccess || per_cu < 1) per_cu = 1;
        (void)hipGetLastError();
        grid = cus * per_cu;
        if (grid > 256) grid = 256;
        if (grid < 1) grid = 256;
    }
    Args a{};
    for (int i = 0; i < 39; ++i) a.in[i] = (const float*)d_in[i];
    a.out = (float*)d_out; a.ws = (unsigned char*)d_ws;
#if MULTI_LAUNCH
    for (int ph = 0; ph < NPH; ++ph) {
        a.ph_lo = ph; a.ph_hi = ph + 1;
        void* args[] = {&a};
        hipError_t e = hipLaunchCooperativeKernel((const void*)fwd_kernel, dim3(grid), dim3(512), args, LDS_BYTES, stream);
        if (e != hipSuccess) { fprintf(stderr, "cooperative launch failed: %s (grid %d)\n", hipGetErrorString(e), grid); break; }
    }
#else
    a.ph_lo = 0; a.ph_hi = NPH;
    void* args[] = {&a};
    hipError_t e = hipLaunchCooperativeKernel((const void*)fwd_kernel, dim3(grid), dim3(512), args, LDS_BYTES, stream);
    if (e != hipSuccess) fprintf(stderr, "cooperative launch failed: %s (grid %d)\n", hipGetErrorString(e), grid);
#endif
}
```

```cpp
#include <hip/hip_runtime.h>
#include <hip/hip_cooperative_groups.h>
#include <cstdio>
namespace cg = cooperative_groups;

#ifndef ONLY
#define ONLY -1
#endif
#define EN(k) (ONLY < 0 || ONLY == (k))
#ifndef SCAN_V
#define SCAN_V 2
#endif
#ifndef DUP_PHASE
#define DUP_PHASE -1
#endif
#ifndef MULTI_LAUNCH
#define MULTI_LAUNCH 0
#endif

#define LAS __attribute__((address_space(3)))
typedef unsigned short bf16_t;
typedef short bf16x8 __attribute__((ext_vector_type(8)));
typedef float f32x4 __attribute__((ext_vector_type(4)));
typedef float f32x2 __attribute__((ext_vector_type(2)));
typedef unsigned u32x4 __attribute__((ext_vector_type(4)));
typedef unsigned u32x2 __attribute__((ext_vector_type(2)));

constexpr int T_ALL = 81920, TP = 16384, TM = 6144, DM = 1024, PROJ_LD = 3504, NPH = 16;
constexpr size_t MiB = 1u << 20;
constexpr size_t WS_SMALL = 1 * MiB;
constexpr int OFF_RS0 = 0, OFF_RSM = T_ALL, OFF_SSQ1 = T_ALL + 8192, OFF_SSQ2 = OFF_SSQ1 + T_ALL, OFF_SSQ3 = OFF_SSQ2 + T_ALL,
              OFF_RS1 = OFF_SSQ3 + T_ALL, OFF_RS2 = OFF_RS1 + T_ALL, OFF_KSC = OFF_RS2 + T_ALL;
constexpr size_t WS_WIN = 8 * MiB, WS_WOUT = 15 * MiB, WS_WQ = 17 * MiB, WS_WKV = 19 * MiB, WS_WO = 23 * MiB, WS_W1 = 25 * MiB, WS_W2 = 33 * MiB, WS_WL = 41 * MiB;
constexpr size_t WS_KB = 44 * MiB, WS_VT = 56 * MiB;
constexpr size_t WS_PROJ = 72 * MiB;
constexpr size_t WS_XB = 620 * MiB, WS_MEMB = 780 * MiB, WS_AL = 620 * MiB, WS_YF = 620 * MiB, WS_GB = 700 * MiB, WS_YB = 780 * MiB, WS_MIXED = 860 * MiB;
constexpr size_t WS_MO = 72 * MiB, WS_Q = 232 * MiB, WS_OB = 392 * MiB, WS_XO = 552 * MiB, WS_HID = 232 * MiB;
constexpr size_t WS_FO_HI = 872 * MiB; constexpr int FO_SPLIT = 4096;
constexpr int LDS_BYTES = 131072 + 256;
#define XCD_BAR_WORDS 3456


typedef __bf16 bf16x2_t __attribute__((ext_vector_type(2)));
__device__ __forceinline__ unsigned pk2(float lo, float hi) { const f32x2 v = {lo, hi}; return __builtin_bit_cast(unsigned, __builtin_convertvector(v, bf16x2_t)); }
__device__ __forceinline__ unsigned f2bf(float f) { return pk2(f, f) & 0xffffu; }
__device__ __forceinline__ float bf2f(unsigned b) { return __builtin_bit_cast(float, (b & 0xffffu) << 16); }
__device__ __forceinline__ float bflo(unsigned w) { return __builtin_bit_cast(float, w << 16); }
__device__ __forceinline__ float bfhi(unsigned w) { return __builtin_bit_cast(float, w & 0xffff0000u); }
__device__ __forceinline__ float wave_sum(float v) {
#pragma unroll
    for (int o = 1; o < 64; o <<= 1) v += __shfl_xor(v, o);
    return v;
}
__device__ __forceinline__ bf16x8 mk8(u32x2 lo, u32x2 hi) { u32x4 w; w.x = lo.x; w.y = lo.y; w.z = hi.x; w.w = hi.y; return __builtin_bit_cast(bf16x8, w); }
__device__ __forceinline__ float sigmoidf_(float z) { return __builtin_amdgcn_rcpf(1.0f + __expf(-z)); }
#define LDS_WAIT() asm volatile("s_waitcnt lgkmcnt(0)" ::: "memory")
#define BAR_LDS() do { asm volatile("s_waitcnt lgkmcnt(0)" ::: "memory"); __builtin_amdgcn_s_barrier(); asm volatile("" ::: "memory"); } while (0)

struct Args { const float* in[39]; float* out; unsigned char* ws; int ph_lo, ph_hi; };
#define GAS __attribute__((address_space(1)))
struct DArgs { const GAS float* in[39]; GAS float* out; GAS unsigned char* ws; int ph_lo, ph_hi; };
typedef const __attribute__((address_space(4))) DArgs* KA;
#define AIN(i) ((const float*)a->in[i])
#define AOUT ((float*)a->out)
#define AWS ((unsigned char*)a->ws)
enum { I_XP = 0, I_XS, I_MP, I_MS, I_G_MIX_PRE, I_W_IN, I_MU_PREV, I_MU_NEXT, I_W0_F, I_W2_F, I_W0_B, I_W2_B, I_A0_F, I_A2_F, I_A0_B, I_A2_B, I_G2, I_K_K, I_K_A, I_R_K,
       I_LNX_W, I_LNX_B, I_GK2_F, I_GKB_F, I_GK2_B, I_GKB_B, I_GLA_NW, I_W_OUT, I_G_MIX_POST, I_G_X_PRE, I_G_MEM, I_WQ, I_WKV, I_WO, I_G_X_POST, I_G_FFN_PRE, I_W_FF1, I_W_FF2, I_G_FFN_POST };

namespace pg8 {
constexpr int BM = 256, BK = 64, HALF = 128, HTB = HALF * BK * 2, STAGE_BYTES = 8 * HTB, NXCD = 8, WGM = 8;
__device__ __forceinline__ int lds_byte(int r, int c) { const int st = (r >> 4) * 2 + (c >> 5), rr = r & 15, cc = c & 31, ob = rr * 64 + cc * 2; return st * 1024 + (ob ^ (((ob >> 9) & 1) << 5)); }
__device__ __forceinline__ void stage_rc(int b, int& R, int& C) { const int st = b / 1024, sb = b % 1024, swz = sb ^ (((sb >> 9) & 1) << 5); R = (st >> 1) * 16 + swz / 64; C = (st & 1) * 32 + (swz % 64) / 2; }
__device__ __forceinline__ int perm32(int rho) { const int n = rho >> 4, i = rho & 15; return 8 * (i >> 2) + 4 * n + (i & 3); }
struct Unit { int pm, pn; };
struct Gemm { const bf16_t* A; const bf16_t* Bt; int M, N, K, lda, ldb; };
struct StaticOrder {
    int nM, nN, nwg, G, c;
    __device__ void init(int M, int N, int G_, int c_) { nM = M / BM; nN = N / BM; nwg = nM * nN; G = G_; c = c_; }
    __device__ bool next(int i, Unit& u) const {
        const long L = (long)i * G + c; if (L >= nwg) return false;
        int wgid = (int)L; { const int q = nwg / NXCD, r = nwg % NXCD, xcd = wgid % NXCD, off = wgid / NXCD; wgid = (xcd < r ? xcd * (q + 1) : r * (q + 1) + (xcd - r) * q) + off; }
        const int nig = WGM * nN, gid = wgid / nig, fm = gid * WGM, gsz = (nM - fm) < WGM ? (nM - fm) : WGM;
        u.pm = fm + ((wgid % nig) % gsz); u.pn = (wgid % nig) / gsz; return true;
    }
};

struct EpiP {
    bf16_t* O; int ldc, ncols; const float* rowscale; const float* colscale; float scal; float* ssq; int act;
    bf16_t* O2; const float* b0; const float* b1; const float* b2; const float* b3;
    bf16_t* Olo; int split;
};
__device__ __forceinline__ void build_epi(KA a, int gi, EpiP& E) {
    unsigned char* ws = AWS; float* sm = (float*)(ws + WS_SMALL);
    E.O = nullptr; E.ldc = 1024; E.ncols = 1 << 30; E.rowscale = nullptr; E.colscale = nullptr; E.scal = 1.0f; E.ssq = nullptr; E.act = 0; E.O2 = nullptr; E.b0 = E.b1 = E.b2 = E.b3 = nullptr; E.Olo = nullptr; E.split = 0;
    switch (gi) {
    case 0: E.O = (bf16_t*)(ws + WS_PROJ); E.ldc = PROJ_LD; E.ncols = PROJ_LD; E.rowscale = sm + OFF_RS0; break;
    case 1: E.O = (bf16_t*)(ws + WS_KB); E.ldc = 1024; E.rowscale = sm + OFF_RSM; break;
    case 2: E.O = (bf16_t*)(ws + WS_VT); E.ldc = TM; E.colscale = sm + OFF_RSM; break;
    case 3: E.O = (bf16_t*)AOUT; E.ldc = 2048; E.act = 2; E.O2 = (bf16_t*)(ws + WS_GB); E.b0 = AIN(I_W0_F); E.b1 = AIN(I_W0_B); E.b2 = AIN(I_A0_F); E.b3 = AIN(I_A0_B); break;
    case 9: E.O = (bf16_t*)(ws + WS_GB); E.ldc = 512; break;
    case 4: E.O = (bf16_t*)(ws + WS_MO); E.ssq = sm + OFF_SSQ1; break;
    case 5: E.O = (bf16_t*)(ws + WS_Q); E.rowscale = sm + OFF_RS1; E.scal = 0.0625f; break;
    case 6: E.O = (bf16_t*)(ws + WS_XO); E.ssq = sm + OFF_SSQ2; break;
    case 7: E.O = (bf16_t*)(ws + WS_HID); E.ldc = 4096; E.rowscale = sm + OFF_RS2; E.act = 1; break;
    default: E.O = (bf16_t*)(ws + WS_FO_HI) - (size_t)FO_SPLIT * 1024; E.Olo = (bf16_t*)(ws + WS_KB); E.split = FO_SPLIT; E.ssq = sm + OFF_SSQ3; break;
    }
}
struct EpiD {
    static constexpr bool PERM = true;
    int gi;
    __device__ __forceinline__ void operator()(const f32x4 (&acc)[2][2][4][2], const Unit& u, int wr, int wc, int fr, int fq) const {
        KA a = (KA)__builtin_amdgcn_kernarg_segment_ptr();
        int gl = gi; asm volatile("" : "+s"(gl), "+s"(a));
        EpiP P; build_epi(a, gl, P);
        const int colbase = u.pn * BM + wc * 32 + 8 * fq;
        const int grp = u.pn >> 1;
        const float* bias = grp == 0 ? P.b0 : (grp == 1 ? P.b1 : (grp == 2 ? P.b2 : P.b3));
#pragma unroll
        for (int ai = 0; ai < 2; ++ai)
#pragma unroll
            for (int m = 0; m < 4; ++m) {
                const int row = u.pm * BM + ai * HALF + wr * 64 + m * 16 + fr;
                const float rsc = P.rowscale ? P.scal * P.rowscale[row] : P.scal;
                float ss = 0.f;
#pragma unroll
                for (int bj = 0; bj < 2; ++bj) {
                    const int col = colbase + bj * HALF;
                    f32x4 v0 = acc[ai][bj][m][0] * rsc, v1 = acc[ai][bj][m][1] * rsc;
                    if (P.colscale) { const f32x4 c0 = *(const f32x4*)(P.colscale + col), c1 = *(const f32x4*)(P.colscale + col + 4); v0 = v0 * c0; v1 = v1 * c1; }
                    if (P.act == 1) {
#pragma unroll
                        for (int j = 0; j < 4; ++j) { const float a0 = v0[j] > 0.f ? v0[j] : 0.f, a1 = v1[j] > 0.f ? v1[j] : 0.f; v0[j] = a0 * a0; v1[j] = a1 * a1; }
                    }
                    bf16_t* dst = (row < P.split ? P.Olo : P.O) + (size_t)row * P.ldc + col;
                    if (P.act == 2) {
                        if (grp < 4) {
                            const int bc = col - grp * 512;
                            const f32x4 c0 = *(const f32x4*)(bias + bc), c1 = *(const f32x4*)(bias + bc + 4);
                            const float mul = grp < 2 ? -0.60653066f : 1.0f;
#pragma unroll
                            for (int j = 0; j < 4; ++j) { v0[j] = mul * sigmoidf_(v0[j] + c0[j]); v1[j] = mul * sigmoidf_(v1[j] + c1[j]); }
                        } else dst = P.O2 + (size_t)row * 512 + (col - 2048);
                    }
                    if (P.ssq) ss += (v0[0] * v0[0] + v0[1] * v0[1]) + (v0[2] * v0[2] + v0[3] * v0[3]) + (v1[0] * v1[0] + v1[1] * v1[1]) + (v1[2] * v1[2] + v1[3] * v1[3]);
                    if (col < P.ncols) { u32x4 w; w.x = pk2(v0[0], v0[1]); w.y = pk2(v0[2], v0[3]); w.z = pk2(v1[0], v1[1]); w.w = pk2(v1[2], v1[3]);
                        if (P.ldc >= 3504) __builtin_nontemporal_store(w, (u32x4*)dst); else *(u32x4*)dst = w; }
                }
                if (P.ssq) { ss += __shfl_xor(ss, 16); ss += __shfl_xor(ss, 32); if (fq == 0) atomicAdd(P.ssq + row, ss); }
            }
    }
};

__device__ __forceinline__ void gemm_phase(LAS unsigned char* lds, const Gemm g, const StaticOrder& S, const EpiD& E, const int tid) {
    const int wid = __builtin_amdgcn_readfirstlane(tid >> 6), lane = tid & 63, wr = wid >> 2, wc = wid & 3, fr = lane & 15, fq = lane >> 4;
    const int K = g.K, nt = K / BK;
    unsigned voffA[2], voffB[2];
#pragma unroll
    for (int i = 0; i < 2; ++i) { int R, C; stage_rc(tid * 16 + i * 8192, R, C); const int Rb = EpiD::PERM ? ((R & ~31) + perm32(R & 31)) : R;
        voffA[i] = (unsigned)(R * g.lda + C) * 2u; voffB[i] = (unsigned)(Rb * g.ldb + C) * 2u; }
    const size_t kstep = (size_t)(BK * 2);
    const size_t hstepA = (size_t)HALF * g.lda * 2, hstepB = (size_t)HALF * g.ldb * 2;
    const size_t tstepA = 2 * hstepA, tstepB = 2 * hstepB;
    const unsigned ldsw = (unsigned)wid * 1024u;
    const int aoff = lds_byte(wr * 64 + fr, fq * 8), boff = lds_byte(wc * 32 + fr, fq * 8);
#define PG8_SA(b, h) (((b) * 2 + (h)) * HTB)
#define PG8_SB(b, h) ((4 + (b) * 2 + (h)) * HTB)
#define PG8_STAGE(bufoff, gbase, voff) do { _Pragma("unroll") for (int _i = 0; _i < 2; ++_i) \
        __builtin_amdgcn_global_load_lds((const unsigned*)((const char*)(gbase) + (voff)[_i]), (LAS unsigned*)(lds + (bufoff) + ldsw + _i * 8192), 16, 0, 0); } while (0)
#define PG8_LDA(dst, b, h) do { _Pragma("unroll") for (int m = 0; m < 4; ++m) _Pragma("unroll") for (int k = 0; k < 2; ++k) dst[m][k] = *(const LAS bf16x8*)(lds + PG8_SA(b, h) + aoff + m * 2048 + k * 1024); } while (0)
#define PG8_LDB(dst, b, h) do { _Pragma("unroll") for (int n = 0; n < 2; ++n) _Pragma("unroll") for (int k = 0; k < 2; ++k) dst[n][k] = *(const LAS bf16x8*)(lds + PG8_SB(b, h) + boff + n * 2048 + k * 1024); } while (0)
#define PG8_MMA(ai, bj, At, Bt) do { __builtin_amdgcn_s_setprio(1); _Pragma("unroll") for (int m = 0; m < 4; ++m) _Pragma("unroll") for (int n = 0; n < 2; ++n) _Pragma("unroll") for (int k = 0; k < 2; ++k) \
        acc[ai][bj][m][n] = __builtin_amdgcn_mfma_f32_16x16x32_bf16(Bt[n][k], At[m][k], acc[ai][bj][m][n], 0, 0, 0); __builtin_amdgcn_s_setprio(0); } while (0)
#define PG8_WAIT_V(n) asm volatile("s_waitcnt vmcnt(" #n ")" ::: "memory")
#define PG8_WAIT_L(n) asm volatile("s_waitcnt lgkmcnt(" #n ")" ::: "memory")
#define PG8_BAR __builtin_amdgcn_s_barrier()
#define PG8_SCHED __builtin_amdgcn_sched_barrier(0)
    Unit cur, nxt; int ui = 0;
    if (!S.next(0, cur)) return;
    f32x4 acc[2][2][4][2];
#pragma unroll
    for (int a = 0; a < 2; ++a)
#pragma unroll
        for (int b = 0; b < 2; ++b)
#pragma unroll
            for (int m = 0; m < 4; ++m)
#pragma unroll
                for (int n = 0; n < 2; ++n) acc[a][b][m][n] = (f32x4){0.f, 0.f, 0.f, 0.f};
    bf16x8 At[4][2], B0[2][2], B1[2][2];
    const char* cA = (const char*)g.A + (size_t)cur.pm * tstepA; const char* cB = (const char*)g.Bt + (size_t)cur.pn * tstepB;
    PG8_STAGE(PG8_SB(0, 0), cB, voffB); PG8_STAGE(PG8_SA(0, 0), cA, voffA); PG8_STAGE(PG8_SB(0, 1), cB + hstepB, voffB); PG8_STAGE(PG8_SA(0, 1), cA + hstepA, voffA);
    if (wr == 1) PG8_BAR;
    PG8_WAIT_V(4); PG8_BAR;
    PG8_STAGE(PG8_SB(1, 0), cB + kstep, voffB); PG8_STAGE(PG8_SA(1, 0), cA + kstep, voffA); PG8_STAGE(PG8_SB(1, 1), cB + hstepB + kstep, voffB);
    PG8_WAIT_V(6); PG8_BAR;
    for (;;) {
        const bool has_next = S.next(ui + 1, nxt);
        const char* nA = has_next ? (const char*)g.A + (size_t)nxt.pm * tstepA : cA; const char* nB = has_next ? (const char*)g.Bt + (size_t)nxt.pn * tstepB : cB;
        for (int t = 0; t < nt; t += 2) {
            const bool last = (t == nt - 2);
            const char* a1 = cA + (size_t)(t + 1) * kstep;
            const char* a2 = last ? nA : cA + (size_t)(t + 2) * kstep; const char* b2 = last ? nB : cB + (size_t)(t + 2) * kstep;
            const char* a3 = a2 + kstep; const char* b3 = b2 + kstep;
            PG8_LDB(B0, 0, 0); PG8_SCHED; PG8_LDA(At, 0, 0); PG8_STAGE(PG8_SA(1, 1), a1 + hstepA, voffA);
            PG8_WAIT_L(8); PG8_BAR; PG8_WAIT_L(0); PG8_MMA(0, 0, At, B0); PG8_BAR; PG8_SCHED;
            PG8_LDB(B1, 0, 1); PG8_STAGE(PG8_SB(0, 0), b2, voffB);
            PG8_BAR; PG8_WAIT_L(0); PG8_MMA(0, 1, At, B1); PG8_BAR;
            PG8_LDA(At, 0, 1); PG8_STAGE(PG8_SA(0, 0), a2, voffA);
            PG8_BAR; PG8_WAIT_L(0); PG8_MMA(1, 0, At, B0); PG8_BAR; PG8_SCHED;
            PG8_STAGE(PG8_SB(0, 1), b2 + hstepB, voffB);
            PG8_WAIT_V(6); PG8_BAR; PG8_MMA(1, 1, At, B1); PG8_BAR;
            PG8_LDB(B0, 1, 0); PG8_SCHED; PG8_LDA(At, 1, 0); PG8_STAGE(PG8_SA(0, 1), a2 + hstepA, voffA);
            PG8_WAIT_L(8); PG8_BAR; PG8_WAIT_L(0); PG8_MMA(0, 0, At, B0); PG8_BAR; PG8_SCHED;
            PG8_LDB(B1, 1, 1); PG8_STAGE(PG8_SB(1, 0), b3, voffB);
            PG8_BAR; PG8_WAIT_L(0); PG8_MMA(0, 1, At, B1); PG8_BAR;
            PG8_LDA(At, 1, 1); PG8_STAGE(PG8_SA(1, 0), a3, voffA);
            PG8_BAR; PG8_WAIT_L(0); PG8_MMA(1, 0, At, B0); PG8_BAR; PG8_SCHED;
            PG8_STAGE(PG8_SB(1, 1), b3 + hstepB, voffB);
            PG8_WAIT_V(6); PG8_BAR; PG8_MMA(1, 1, At, B1); PG8_BAR;
        }
        E(acc, cur, wr, wc, fr, fq);
        if (!has_next) break;
#pragma unroll
        for (int a = 0; a < 2; ++a)
#pragma unroll
            for (int b = 0; b < 2; ++b)
#pragma unroll
                for (int m = 0; m < 4; ++m)
#pragma unroll
                    for (int n = 0; n < 2; ++n) acc[a][b][m][n] = (f32x4){0.f, 0.f, 0.f, 0.f};
        cur = nxt; cA = nA; cB = nB; ++ui;
    }
    PG8_WAIT_V(0);
    if (wr == 0) PG8_BAR;
    PG8_BAR;
#undef PG8_SA
#undef PG8_SB
#undef PG8_STAGE
#undef PG8_LDA
#undef PG8_LDB
#undef PG8_MMA
#undef PG8_WAIT_V
#undef PG8_WAIT_L
#undef PG8_BAR
#undef PG8_SCHED
}
}

__device__ __forceinline__ const float* xrow_ptr(KA a, int t) { return t < TP ? AIN(I_XP) + (size_t)t * DM : AIN(I_XS) + (size_t)(t - TP) * DM; }
__device__ __forceinline__ void seq_pos(int t, int& pos, int& len) { if (t < TP) { pos = t & 2047; len = 2048; } else { pos = (t - TP) & 4095; len = 4096; } }

__device__ __forceinline__ void transpose_item(const float* W, int K, int N, int Npad, bf16_t* WT, const float* g, LAS float* scr, int item, int lane) {
    const int nblk = Npad / 32, kb = item / nblk, nb = item % nblk, k0 = 64 * kb, n0 = 32 * nb;
#pragma unroll 8
    for (int i = 0; i < 32; ++i) { const int kk = 2 * i + (lane >> 5), n = n0 + (lane & 31); float v = (n < N) ? W[(size_t)(k0 + kk) * N + n] : 0.f; if (g) v *= g[k0 + kk]; scr[kk * 33 + (lane & 31)] = v; }
    LDS_WAIT();
    const int c = lane & 7;
#pragma unroll
    for (int j = 0; j < 4; ++j) { const int n = (lane >> 3) + 8 * j; const LAS float* s = scr + (8 * c) * 33 + n;
        u32x4 o; o.x = pk2(s[0 * 33], s[1 * 33]); o.y = pk2(s[2 * 33], s[3 * 33]); o.z = pk2(s[4 * 33], s[5 * 33]); o.w = pk2(s[6 * 33], s[7 * 33]);
        *(u32x4*)(WT + (size_t)(n0 + n) * K + k0 + 8 * c) = o; }
    LDS_WAIT();
}
__device__ __forceinline__ void row_to_bf16(const float* xrow, bf16_t* orow, float* rs, int lane) {
    const f32x4* xr = (const f32x4*)xrow + lane;
    f32x4 v[4]; float s = 0.f;
#pragma unroll
    for (int j = 0; j < 4; ++j) { v[j] = xr[64 * j]; s += (v[j].x * v[j].x + v[j].y * v[j].y) + (v[j].z * v[j].z + v[j].w * v[j].w); }
    s = wave_sum(s);
    u32x2* o8 = (u32x2*)orow + lane;
#pragma unroll
    for (int j = 0; j < 4; ++j) { u32x2 w; w.x = pk2(v[j].x, v[j].y); w.y = pk2(v[j].z, v[j].w); o8[64 * j] = w; }
    if (lane == 0) *rs = 1.0f / sqrtf(s * (1.0f / DM) + 1e-6f);
}
__device__ __forceinline__ void p0_phase(KA a, LAS unsigned char* lds, int G, const int tid, const int bid) {
    const int wid = tid >> 6, lane = tid & 63;
    unsigned char* ws = AWS;
    float* sm = (float*)(ws + WS_SMALL);
    LAS float* scr = (LAS float*)(lds + wid * 8704);
    const int gw = bid * 8 + wid, NGW = G * 8;
    constexpr int I0 = 16 * 112, I1 = 16 * 32, I2 = 16 * 32, I3 = 16 * 64, I4 = 16 * 32, I5 = 16 * 128, I6 = 64 * 32;
    constexpr int NIT = I0 + I1 + I2 + I3 + I4 + I5 + I6;
    for (int it = gw; it < NIT; it += NGW) {
        int r = it;
        if (r < I0) { transpose_item(AIN(I_W_IN), 1024, 3504, 3584, (bf16_t*)(ws + WS_WIN), AIN(I_G_MIX_PRE), scr, r, lane); continue; } r -= I0;
        if (r < I1) { transpose_item(AIN(I_W_OUT), 1024, 1024, 1024, (bf16_t*)(ws + WS_WOUT), nullptr, scr, r, lane); continue; } r -= I1;
        if (r < I2) { transpose_item(AIN(I_WQ), 1024, 1024, 1024, (bf16_t*)(ws + WS_WQ), AIN(I_G_X_PRE), scr, r, lane); continue; } r -= I2;
        if (r < I3) { transpose_item(AIN(I_WKV), 1024, 2048, 2048, (bf16_t*)(ws + WS_WKV), AIN(I_G_MEM), scr, r, lane); continue; } r -= I3;
        if (r < I4) { transpose_item(AIN(I_WO), 1024, 1024, 1024, (bf16_t*)(ws + WS_WO), nullptr, scr, r, lane); continue; } r -= I4;
        if (r < I5) { transpose_item(AIN(I_W_FF1), 1024, 4096, 4096, (bf16_t*)(ws + WS_W1), AIN(I_G_FFN_PRE), scr, r, lane); continue; } r -= I5;
        transpose_item(AIN(I_W_FF2), 4096, 1024, 1024, (bf16_t*)(ws + WS_W2), nullptr, scr, r, lane);
    }
    if (bid == 0) for (int i = tid; i < XCD_BAR_WORDS; i += 512) ((unsigned*)ws)[i] = 0u;
    {
        bf16_t* WL = (bf16_t*)(ws + WS_WL);
        for (int idx = bid * 512 + tid; idx < 2560 * 512; idx += G * 512) {
            const int n = idx >> 9, k = idx & 511; const int grp = n >> 9, nn = n & 511;
            float v = 0.f;
            if (grp < 4) { const int kl = k - grp * 64; if (kl >= 0 && kl < 64) { const float* w = grp == 0 ? AIN(I_W2_F) : (grp == 1 ? AIN(I_W2_B) : (grp == 2 ? AIN(I_A2_F) : AIN(I_A2_B))); v = w[kl * 512 + nn]; } }
            else { const int kl = k - 256; if (kl >= 0 && kl < 160) v = AIN(I_G2)[kl * 512 + nn]; }
            WL[idx] = (bf16_t)f2bf(v);
        }
    }
    bf16_t* XB = (bf16_t*)(ws + WS_XB); bf16_t* MB = (bf16_t*)(ws + WS_MEMB);
    for (int t0 = gw; t0 < T_ALL; t0 += 4 * NGW) {
        f32x4 v[4][4]; int tt[4];
#pragma unroll
        for (int q = 0; q < 4; ++q) { tt[q] = t0 + q * NGW < T_ALL ? t0 + q * NGW : t0; const f32x4* xr = (const f32x4*)xrow_ptr(a, tt[q]) + lane;
#pragma unroll
            for (int j = 0; j < 4; ++j) v[q][j] = __builtin_nontemporal_load(xr + 64 * j); }
#pragma unroll
        for (int q = 0; q < 4; ++q) {
            if (q > 0 && tt[q] == t0) continue;
            float s = 0.f;
#pragma unroll
            for (int j = 0; j < 4; ++j) s += (v[q][j].x * v[q][j].x + v[q][j].y * v[q][j].y) + (v[q][j].z * v[q][j].z + v[q][j].w * v[q][j].w);
            s = wave_sum(s);
            u32x2* o8 = (u32x2*)(XB + (size_t)tt[q] * DM) + lane;
#pragma unroll
            for (int j = 0; j < 4; ++j) { u32x2 w; w.x = pk2(v[q][j].x, v[q][j].y); w.y = pk2(v[q][j].z, v[q][j].w); o8[64 * j] = w; }
            if (lane == 0) sm[OFF_RS0 + tt[q]] = 1.0f / sqrtf(s * (1.0f / DM) + 1e-6f);
        }
    }
    for (int m = gw; m < TM; m += NGW) { const float* mr = m < 2048 ? AIN(I_MP) + (size_t)m * DM : AIN(I_MS) + (size_t)(m - 2048) * DM; row_to_bf16(mr, MB + (size_t)m * DM, sm + OFF_RSM + m, lane); }
    for (int i = bid * 512 + tid; i < 3 * T_ALL; i += G * 512) sm[OFF_SSQ1 + i] = 0.f;
}

__device__ __forceinline__ void ld8nt(const bf16_t* p, float (&o)[8]) { const u32x4 w = __builtin_nontemporal_load((const u32x4*)p); o[0] = bflo(w.x); o[1] = bfhi(w.x); o[2] = bflo(w.y); o[3] = bfhi(w.y); o[4] = bflo(w.z); o[5] = bfhi(w.z); o[6] = bflo(w.w); o[7] = bfhi(w.w); }
__device__ __forceinline__ void ld8(const bf16_t* p, float (&o)[8]) { const u32x4 w = *(const u32x4*)p; o[0] = bflo(w.x); o[1] = bfhi(w.x); o[2] = bflo(w.y); o[3] = bfhi(w.y); o[4] = bflo(w.z); o[5] = bfhi(w.z); o[6] = bflo(w.w); o[7] = bfhi(w.w); }
__device__ __forceinline__ void ldf8(const float* p, float (&o)[8]) { const f32x4 a0 = *(const f32x4*)p, a1 = *(const f32x4*)(p + 4); o[0] = a0.x; o[1] = a0.y; o[2] = a0.z; o[3] = a0.w; o[4] = a1.x; o[5] = a1.y; o[6] = a1.z; o[7] = a1.w; }
__device__ __forceinline__ u32x4 st8(const float (&v)[8]) { u32x4 w; w.x = pk2(v[0], v[1]); w.y = pk2(v[2], v[3]); w.z = pk2(v[4], v[5]); w.w = pk2(v[6], v[7]); return w; }
__device__ __forceinline__ void shift8(const bf16_t* P, int col, bool first, bool last, const float (&mp)[8], const float (&mn)[8], float (&o)[8]) {
    float c[8], pv[8], nx[8];
    ld8(P + col, c); ld8(P + col - (first ? 0 : PROJ_LD), pv); ld8(P + col + (last ? 0 : PROJ_LD), nx);
#pragma unroll
    for (int j = 0; j < 8; ++j) { const float pp = first ? 0.f : pv[j], pn = last ? 0.f : nx[j]; o[j] = c[j] + mp[j] * (pp - c[j]) + mn[j] * (pn - c[j]); }
}
__device__ __forceinline__ void p2_phase(KA a, int G, const int tid, const int bid) {
    const int wid = tid >> 6, lane = tid & 63;
    unsigned char* ws = AWS;
    const bf16_t* PROJ = (const bf16_t*)(ws + WS_PROJ); bf16_t* AL = (bf16_t*)(ws + WS_AL); float* KSC = (float*)(ws + WS_SMALL) + OFF_KSC;
    const int gw = bid * 8 + wid, NGW = G * 8;
    const int lcol = 1536 + 8 * (lane < 52 ? lane : 0), kcol = 512 + 8 * lane;
    float mpl[8], mnl[8], mpk[8], mnk[8], kkv[8];
    ldf8(AIN(I_MU_PREV) + lcol, mpl); ldf8(AIN(I_MU_NEXT) + lcol, mnl); ldf8(AIN(I_MU_PREV) + kcol, mpk); ldf8(AIN(I_MU_NEXT) + kcol, mnk); ldf8(AIN(I_K_K) + 8 * lane, kkv);
    for (int t = gw; t < T_ALL; t += NGW) {
        int pos, len; seq_pos(t, pos, len); const bool first = pos == 0, last = pos == len - 1;
        const bf16_t* P = PROJ + (size_t)t * PROJ_LD;
        float sh[8], kk[8];
        shift8(P, lcol, first, last, mpl, mnl, sh);
        shift8(P, kcol, first, last, mpk, mnk, kk);
        if (lane < 16) {
#pragma unroll
            for (int j = 0; j < 8; ++j) sh[j] = 1.0f - 2.0f * __builtin_amdgcn_rcpf(__expf(2.0f * sh[j]) + 1.0f);
        } else if (lane >= 32) {
#pragma unroll
            for (int j = 0; j < 8; ++j) sh[j] = sigmoidf_(sh[j]);
        }
        if (lane >= 52) {
#pragma unroll
            for (int j = 0; j < 8; ++j) sh[j] = 0.f;
        }
        *(u32x4*)(AL + (size_t)t * 512 + 8 * lane) = st8(sh);
        float s = 0.f;
#pragma unroll
        for (int j = 0; j < 8; ++j) { const float x = kk[j] * kkv[j]; s += x * x; }
        s += __shfl_xor(s, 1); s += __shfl_xor(s, 2); s += __shfl_xor(s, 4);
        if ((lane & 7) == 0) KSC[(size_t)t * 8 + (lane >> 3)] = 1.0f / sqrtf(s + 1e-12f);
    }
}

constexpr int SC_TB = 8;
__device__ __forceinline__ void scan_phase(KA a, LAS unsigned char* lds, int G, const int tid, const int bid) {
    const int wid = __builtin_amdgcn_readfirstlane(tid >> 6), lane = tid & 63;
    unsigned char* ws = AWS;
    const bf16_t* PROJ = (const bf16_t*)(ws + WS_PROJ); const bf16_t* LO = (const bf16_t*)AOUT; const float* KSC = (const float*)(ws + WS_SMALL) + OFF_KSC;
    LAS float* L = (LAS float*)(lds + wid * (SC_TB * 6 * 256));
    for (int u = wid * G + bid; u < 384; u += 8 * G) {
        int row0, len, h, dir;
        if (u < 256) { row0 = TP + (u >> 4) * 4096; len = 4096; h = (u >> 1) & 7; dir = u & 1; }
        else { const int v = u - 256; row0 = (v >> 4) * 2048; len = 2048; h = (v >> 1) & 7; dir = v & 1; }
        const int c = h * 64 + lane;
        const float mpr = AIN(I_MU_PREV)[c], mnr = AIN(I_MU_NEXT)[c], mpk = AIN(I_MU_PREV)[512 + c], mnk = AIN(I_MU_NEXT)[512 + c], mpv = AIN(I_MU_PREV)[1024 + c], mnv = AIN(I_MU_NEXT)[1024 + c];
        const float kkc = AIN(I_K_K)[c], kac = AIN(I_K_A)[c];
        bf16_t* Y = (bf16_t*)(ws + (dir ? WS_YB : WS_YF));
        const int d = dir ? -1 : 1, t0 = dir ? len - 1 : 0;
        float S[64];
#pragma unroll
        for (int j = 0; j < 64; ++j) S[j] = 0.f;
        float rB = 0.f, kB = 0.f, vB = 0.f, rC, kC, vC;
        { const bf16_t* P = PROJ + (size_t)(row0 + t0) * PROJ_LD; rC = bf2f(P[c]); kC = bf2f(P[512 + c]); vC = bf2f(P[1024 + c]); }
        unsigned rawR[SC_TB], rawK[SC_TB], rawV[SC_TB], rawL[SC_TB], rawA[SC_TB]; float rawS[SC_TB];
        const int nb = len / SC_TB;
#define SC_LOAD(b_) do { _Pragma("unroll") for (int s = 0; s < SC_TB; ++s) { const int t = t0 + d * ((b_) * SC_TB + s); int ta = t + d; ta = ta < 0 ? 0 : (ta >= len ? len - 1 : ta); \
            const bf16_t* P = PROJ + (size_t)(row0 + ta) * PROJ_LD; rawR[s] = P[c]; rawK[s] = P[512 + c]; rawV[s] = P[1024 + c]; \
            const bf16_t* Q = LO + (size_t)(row0 + t) * 2048; rawL[s] = Q[dir * 512 + c]; rawA[s] = Q[1024 + dir * 512 + c]; rawS[s] = KSC[(size_t)(row0 + t) * 8 + h]; } } while (0)
        SC_LOAD(0);
        for (int b = 0; b < nb; ++b) {
#pragma unroll
            for (int s = 0; s < SC_TB; ++s) {
                const int t = t0 + d * (b * SC_TB + s); const int ta = t + d; const bool va = ta >= 0 && ta < len;
                const float rA = va ? bf2f(rawR[s]) : 0.f, kA = va ? bf2f(rawK[s]) : 0.f, vA = va ? bf2f(rawV[s]) : 0.f;
                const float rp = dir ? rA : rB, rn = dir ? rB : rA, kp = dir ? kA : kB, kn = dir ? kB : kA, vp = dir ? vA : vB, vn = dir ? vB : vA;
                const float r = rC + mpr * (rp - rC) + mnr * (rn - rC);
                const float k = kC + mpk * (kp - kC) + mnk * (kn - kC);
                const float v = vC + mpv * (vp - vC) + mnv * (vn - vC);
                const float av = bf2f(rawA[s]), w = __expf(bf2f(rawL[s]));
                const float kk = k * kkc * rawS[s];
                LAS float* Ls = L + s * 384;
                Ls[lane] = w; Ls[64 + lane] = kk * av; Ls[128 + lane] = -kk; Ls[192 + lane] = k * (1.0f + (av - 1.0f) * kac); Ls[256 + lane] = r; Ls[320 + lane] = v;
                rB = rC; kB = kC; vB = vC; rC = rA; kC = kA; vC = vA;
            }
            if (b + 1 < nb) SC_LOAD(b + 1);
            LDS_WAIT();
#pragma unroll 2
            for (int s = 0; s < SC_TB; ++s) {
                const LAS float* Ls = L + s * 384;
                const LAS f32x4* W4 = (const LAS f32x4*)Ls; const LAS f32x4* B4 = (const LAS f32x4*)(Ls + 64); const LAS f32x4* N4 = (const LAS f32x4*)(Ls + 128);
                const LAS f32x4* K4 = (const LAS f32x4*)(Ls + 192); const LAS f32x4* R4 = (const LAS f32x4*)(Ls + 256);
                const float v = Ls[320 + lane];
                float s0 = 0.f, s1 = 0.f, s2 = 0.f, s3 = 0.f;
#pragma unroll
                for (int q = 0; q < 16; ++q) { const f32x4 n4 = N4[q]; s0 += S[4 * q] * n4.x; s1 += S[4 * q + 1] * n4.y; s2 += S[4 * q + 2] * n4.z; s3 += S[4 * q + 3] * n4.w; }
                const float sa = (s0 + s1) + (s2 + s3);
                float y0 = 0.f, y1 = 0.f, y2 = 0.f, y3 = 0.f;
#pragma unroll
                for (int q = 0; q < 16; ++q) {
                    const f32x4 w4 = W4[q], b4 = B4[q], k4 = K4[q], r4 = R4[q];
                    S[4 * q]     = S[4 * q]     * w4.x + (sa * b4.x + v * k4.x); y0 += S[4 * q]     * r4.x;
                    S[4 * q + 1] = S[4 * q + 1] * w4.y + (sa * b4.y + v * k4.y); y1 += S[4 * q + 1] * r4.y;
                    S[4 * q + 2] = S[4 * q + 2] * w4.z + (sa * b4.z + v * k4.z); y2 += S[4 * q + 2] * r4.z;
                    S[4 * q + 3] = S[4 * q + 3] * w4.w + (sa * b4.w + v * k4.w); y3 += S[4 * q + 3] * r4.w;
                }
                const int t = t0 + d * (b * SC_TB + s);
                Y[(size_t)(row0 + t) * 512 + c] = (bf16_t)f2bf((y0 + y1) + (y2 + y3));
            }
            LDS_WAIT();
        }
#undef SC_LOAD
    }
}


__device__ __forceinline__ void scan2_phase(KA a, LAS unsigned char* lds, int G, const int tid, const int bid) {
    const int wid = __builtin_amdgcn_readfirstlane(tid >> 6), lane = tid & 63, fr = lane & 15, fq = lane >> 4;
    const int grp = wid >> 2, r = wid & 3;
    const int mid = (r - grp) & 3;
    unsigned char* ws = AWS;
    const bf16_t* PROJ = (const bf16_t*)(ws + WS_PROJ); const bf16_t* LO = (const bf16_t*)AOUT; const float* KSC = (const float*)(ws + WS_SMALL) + OFF_KSC;
    LAS unsigned char* gl0 = lds + grp * 57344;
    const int npair = bid < 128 ? 1 : 2, pbase = bid < 128 ? bid : 128 + 2 * (bid - 128);
    for (int pi = 0; pi < npair; ++pi) {
        const int p = pbase + pi;
        const int u = 2 * p + grp;
        int row0, len, h, dir;
        if (u < 256) { row0 = TP + (u >> 4) * 4096; len = 4096; h = (u >> 1) & 7; dir = u & 1; }
        else { const int v = u - 256; row0 = (v >> 4) * 2048; len = 2048; h = (v >> 1) & 7; dir = v & 1; }
        const int c = h * 64 + lane;
        const float mpr = AIN(I_MU_PREV)[c], mnr = AIN(I_MU_NEXT)[c], mpk = AIN(I_MU_PREV)[512 + c], mnk = AIN(I_MU_NEXT)[512 + c], mpv = AIN(I_MU_PREV)[1024 + c], mnv = AIN(I_MU_NEXT)[1024 + c];
        const float kkc = AIN(I_K_K)[c], kac = AIN(I_K_A)[c];
        bf16_t* Y = (bf16_t*)(ws + (dir ? WS_YB : WS_YF));
        f32x4 accS[4];
#pragma unroll
        for (int j = 0; j < 4; ++j) accS[j] = (f32x4){0.f, 0.f, 0.f, 0.f};
        unsigned rawR[6], rawK[6], rawV[6], rawL[4], rawA[4]; float rawS[4];
        const int nb = len / 16;
#define SC2_LOAD(b_) do { const int tau0 = (b_) * 16 + 4 * r; const int tmin = dir ? len - 4 - tau0 : tau0; \
            _Pragma("unroll") for (int m = 0; m < 6; ++m) { int ar = tmin - 1 + m; ar = ar < 0 ? 0 : (ar >= len ? len - 1 : ar); const bf16_t* P = PROJ + (size_t)(row0 + ar) * PROJ_LD; rawR[m] = P[c]; rawK[m] = P[512 + c]; rawV[m] = P[1024 + c]; } \
            _Pragma("unroll") for (int i = 0; i < 4; ++i) { const int t = dir ? len - 1 - tau0 - i : tau0 + i; const bf16_t* Q = LO + (size_t)(row0 + t) * 2048; rawL[i] = Q[dir * 512 + c]; rawA[i] = Q[1024 + dir * 512 + c]; rawS[i] = KSC[(size_t)(row0 + t) * 8 + h]; } } while (0)
        SC2_LOAD(0);
        for (int b = 0; b < nb; ++b) {
            LAS unsigned char* gl = gl0 + (b & 1) * 28672;
            LAS bf16_t* At = (LAS bf16_t*)gl; LAS bf16_t* Rt = At + 16 * 72; LAS bf16_t* Bs = Rt + 16 * 72; LAS bf16_t* Ks = Bs + 16 * 72;
            LAS bf16_t* BT = Ks + 16 * 72; LAS bf16_t* KT = BT + 64 * 24; LAS bf16_t* VT = KT + 64 * 24;
            LAS bf16_t* MkaT = VT + 64 * 24; LAS bf16_t* MbrT = MkaT + 16 * 24; LAS bf16_t* MkrT = MbrT + 16 * 24;
            LAS float* Nf = (LAS float*)(MkrT + 16 * 24); LAS float* TTf = Nf + 16 * 20; LAS float* Pc = TTf + 16 * 20; LAS float* tot = Pc + 64;
            const int tau0 = b * 16 + 4 * r; const int tmin = dir ? len - 4 - tau0 : tau0;
            float xr[6], xk[6], xv[6];
#pragma unroll
            for (int m = 0; m < 6; ++m) { const int ar = tmin - 1 + m; const bool ok = ar >= 0 && ar < len; xr[m] = ok ? bf2f(rawR[m]) : 0.f; xk[m] = ok ? bf2f(rawK[m]) : 0.f; xv[m] = ok ? bf2f(rawV[m]) : 0.f; }
            float Lv[4], cl[4];
#pragma unroll
            for (int i = 0; i < 4; ++i) { Lv[i] = bf2f(rawL[i]); cl[i] = i ? cl[i - 1] + Lv[i] : Lv[i]; }
            tot[r * 64 + lane] = cl[3];
            BAR_LDS();
            float off = 0.f, all = 0.f;
#pragma unroll
            for (int w2 = 0; w2 < 4; ++w2) { const float x = tot[w2 * 64 + lane]; all += x; if (w2 < r) off += x; }
            float bt[4], kt[4], vt[4];
#pragma unroll
            for (int i = 0; i < 4; ++i) {
                const float rc = dir ? xr[4 - i] : xr[1 + i], rp = dir ? xr[3 - i] : xr[i], rn = dir ? xr[5 - i] : xr[2 + i];
                const float kc = dir ? xk[4 - i] : xk[1 + i], kp = dir ? xk[3 - i] : xk[i], kn = dir ? xk[5 - i] : xk[2 + i];
                const float vc = dir ? xv[4 - i] : xv[1 + i], vp = dir ? xv[3 - i] : xv[i], vn = dir ? xv[5 - i] : xv[2 + i];
                const float rr = rc + mpr * (rp - rc) + mnr * (rn - rc);
                const float k = kc + mpk * (kp - kc) + mnk * (kn - kc);
                const float v = vc + mpv * (vp - vc) + mnv * (vn - vc);
                const float av = bf2f(rawA[i]);
                const float cum = cl[i] + off;
                const float Pin = __expf(cum), Pprev = __expf(cum - Lv[i]), Pinv = __expf(-cum);
                const float kk = k * kkc * rawS[i];
                const float bb = kk * av * Pinv, kd = k * (1.0f + (av - 1.0f) * kac) * Pinv;
                const int tau = 4 * r + i;
                At[tau * 72 + lane] = (bf16_t)f2bf(-kk * Pprev); Rt[tau * 72 + lane] = (bf16_t)f2bf(rr * Pin); Bs[tau * 72 + lane] = (bf16_t)f2bf(bb); Ks[tau * 72 + lane] = (bf16_t)f2bf(kd);
                bt[i] = bb; kt[i] = kd; vt[i] = v;
            }
            { u32x2 w; w.x = pk2(bt[0], bt[1]); w.y = pk2(bt[2], bt[3]); *(LAS u32x2*)(BT + lane * 24 + 4 * r) = w; }
            { u32x2 w; w.x = pk2(kt[0], kt[1]); w.y = pk2(kt[2], kt[3]); *(LAS u32x2*)(KT + lane * 24 + 4 * r) = w; }
            { u32x2 w; w.x = pk2(vt[0], vt[1]); w.y = pk2(vt[2], vt[3]); *(LAS u32x2*)(VT + lane * 24 + 4 * r) = w; }
            if (r == 0) Pc[lane] = __expf(all);
            if (b + 1 < nb) SC2_LOAD(b + 1);
            BAR_LDS();
            {
                const LAS bf16_t* As = (mid & 1) ? Ks : Bs; const LAS bf16_t* Bsrc = (mid < 2) ? At : Rt;
                f32x4 m = (f32x4){0.f, 0.f, 0.f, 0.f};
#pragma unroll
                for (int ks = 0; ks < 2; ++ks) { const bf16x8 af = *(const LAS bf16x8*)(As + fr * 72 + 32 * ks + 8 * fq), bfv = *(const LAS bf16x8*)(Bsrc + fr * 72 + 32 * ks + 8 * fq); m = __builtin_amdgcn_mfma_f32_16x16x32_bf16(af, bfv, m, 0, 0, 0); }
#pragma unroll
                for (int i = 0; i < 4; ++i) { const int s = 4 * fq + i; const bool keep = (s < fr) || (mid >= 2 && s == fr); m[i] = keep ? m[i] : 0.f; }
                if (mid == 0) {
#pragma unroll
                    for (int i = 0; i < 4; ++i) Nf[(4 * fq + i) * 20 + fr] = m[i];
                }
                else { u32x2 w; w.x = pk2(m[0], m[1]); w.y = pk2(m[2], m[3]); LAS bf16_t* dst = mid == 1 ? MkaT : (mid == 2 ? MbrT : MkrT); *(LAS u32x2*)(dst + fr * 24 + 4 * fq) = w; }
            }
            if (mid == 0) {
                float acc[16];
#pragma unroll
                for (int tp = 0; tp < 16; ++tp) acc[tp] = (fr == tp) ? 1.0f : 0.f;
#pragma unroll
                for (int s2 = 0; s2 < 15; ++s2) {
                    const float ts = acc[s2];
#pragma unroll
                    for (int q = 0; q < 4; ++q) {
                        if (4 * q + 3 > s2) {
                            const f32x4 n4 = *(const LAS f32x4*)(Nf + s2 * 20 + 4 * q);
                            if (4 * q + 0 > s2) acc[4 * q + 0] += ts * n4.x;
                            if (4 * q + 1 > s2) acc[4 * q + 1] += ts * n4.y;
                            if (4 * q + 2 > s2) acc[4 * q + 2] += ts * n4.z;
                            if (4 * q + 3 > s2) acc[4 * q + 3] += ts * n4.w;
                        }
                    }
                }
                if (fq == 0) {
#pragma unroll
                    for (int tp = 0; tp < 16; ++tp) TTf[tp * 20 + fr] = acc[tp];
                }
            }
            BAR_LDS();
            const u32x2 z2 = (u32x2){0u, 0u};
            bf16x8 sb[2];
#pragma unroll
            for (int kb = 0; kb < 2; ++kb) { u32x4 w; w.x = pk2(accS[2 * kb][0], accS[2 * kb][1]); w.y = pk2(accS[2 * kb][2], accS[2 * kb][3]); w.z = pk2(accS[2 * kb + 1][0], accS[2 * kb + 1][1]); w.w = pk2(accS[2 * kb + 1][2], accS[2 * kb + 1][3]); sb[kb] = __builtin_bit_cast(bf16x8, w); }
            const u32x2 vlo = *(const LAS u32x2*)(VT + (16 * r + fr) * 24 + 4 * fq);
            f32x4 accX = (f32x4){0.f, 0.f, 0.f, 0.f}, accY = (f32x4){0.f, 0.f, 0.f, 0.f};
#pragma unroll
            for (int kb = 0; kb < 2; ++kb) { const u32x2 lo = *(const LAS u32x2*)(At + fr * 72 + 32 * kb + 4 * fq), hi = *(const LAS u32x2*)(At + fr * 72 + 32 * kb + 16 + 4 * fq); accX = __builtin_amdgcn_mfma_f32_16x16x32_bf16(mk8(lo, hi), sb[kb], accX, 0, 0, 0); }
            { const u32x2 alo = *(const LAS u32x2*)(MkaT + fr * 24 + 4 * fq); accX = __builtin_amdgcn_mfma_f32_16x16x32_bf16(mk8(alo, z2), mk8(vlo, z2), accX, 0, 0, 0); }
#pragma unroll
            for (int kb = 0; kb < 2; ++kb) { const u32x2 lo = *(const LAS u32x2*)(Rt + fr * 72 + 32 * kb + 4 * fq), hi = *(const LAS u32x2*)(Rt + fr * 72 + 32 * kb + 16 + 4 * fq); accY = __builtin_amdgcn_mfma_f32_16x16x32_bf16(mk8(lo, hi), sb[kb], accY, 0, 0, 0); }
            {
                f32x4 accSA = (f32x4){0.f, 0.f, 0.f, 0.f};
#pragma unroll
                for (int kk = 0; kk < 4; ++kk) accSA = __builtin_amdgcn_mfma_f32_16x16x4f32(TTf[fr * 20 + 4 * fq + kk], accX[kk], accSA, 0, 0, 0);
                u32x2 sav; sav.x = pk2(accSA[0], accSA[1]); sav.y = pk2(accSA[2], accSA[3]);
                const bf16x8 bsv = mk8(sav, vlo);
                { const u32x2 lo = *(const LAS u32x2*)(MbrT + fr * 24 + 4 * fq), hi = *(const LAS u32x2*)(MkrT + fr * 24 + 4 * fq); accY = __builtin_amdgcn_mfma_f32_16x16x32_bf16(mk8(lo, hi), bsv, accY, 0, 0, 0); }
#pragma unroll
                for (int i = 0; i < 4; ++i) { const int tau = b * 16 + 4 * fq + i; const int t = dir ? len - 1 - tau : tau; Y[(size_t)(row0 + t) * 512 + h * 64 + 16 * r + fr] = (bf16_t)f2bf(accY[i]); }
#pragma unroll
                for (int jt = 0; jt < 4; ++jt) {
                    const u32x2 lo = *(const LAS u32x2*)(BT + (16 * jt + fr) * 24 + 4 * fq), hi = *(const LAS u32x2*)(KT + (16 * jt + fr) * 24 + 4 * fq);
                    accS[jt] = __builtin_amdgcn_mfma_f32_16x16x32_bf16(mk8(lo, hi), bsv, accS[jt], 0, 0, 0);
                    const f32x4 pc4 = *(const LAS f32x4*)(Pc + 16 * jt + 4 * fq);
                    accS[jt] = accS[jt] * pc4;
                }
            }
        }
        BAR_LDS();
#undef SC2_LOAD
    }
}

__device__ __forceinline__ void gla_phase(KA a, LAS unsigned char* lds, int G, const int tid, const int bid) {
    const int wid = __builtin_amdgcn_readfirstlane(tid >> 6), lane = tid & 63, fr = lane & 15, fq = lane >> 4;
    unsigned char* ws = AWS;
    const bf16_t* PROJ = (const bf16_t*)(ws + WS_PROJ); bf16_t* MIX = (bf16_t*)(ws + WS_MIXED);
    constexpr int SD = 72;
    LAS bf16_t* Qin = (LAS bf16_t*)lds; LAS bf16_t* Kin = Qin + 64 * SD; LAS bf16_t* KdT = Kin + 64 * SD; LAS bf16_t* VT = KdT + 64 * SD; LAS bf16_t* STt = VT + 128 * SD;
    LAS float* tot = (LAS float*)(STt + 128 * SD); LAS float* bl = tot + 8 * 64;
    const int tt = wid & 3, eh = wid >> 2, dt = wid & 3, etg = (wid >> 2) * 4;
    const int gj = bid - 160;
    for (int ui = 0; ui < 2; ++ui) {
        const int u = 2 * gj + ui;
        int row0, len, h, dir;
        if (u < 128) { row0 = TP + (u >> 3) * 4096; len = 4096; h = (u >> 1) & 3; dir = u & 1; } else { const int v = u - 128; row0 = (v >> 3) * 2048; len = 2048; h = (v >> 1) & 3; dir = v & 1; }
        const int nch = len / 64;
        const int dtile = wid & 3, th = wid >> 2, d0 = 16 * dtile;
        u32x2 gb2;
        { const float* g2 = AIN(dir ? I_GK2_B : I_GK2_F) + h * 64 + d0 + fr; gb2.x = pk2(g2[(4 * fq) * 256], g2[(4 * fq + 1) * 256]); gb2.y = pk2(g2[(4 * fq + 2) * 256], g2[(4 * fq + 3) * 256]); }
        const float gkb = AIN(dir ? I_GKB_B : I_GKB_F)[h * 64 + d0 + fr];
        f32x4 accS[4];
#pragma unroll
        for (int e4 = 0; e4 < 4; ++e4) accS[e4] = (f32x4){0.f, 0.f, 0.f, 0.f};
        BAR_LDS();
        for (int i = tid; i < 128 * SD / 2; i += 512) ((LAS unsigned*)STt)[i] = 0u;
        unsigned qraw[8], kraw[8], vraw[16]; u32x2 graw[2];
        const unsigned qoff = (unsigned)((32 * th + 4 * fq) * PROJ_LD + h * 64 + d0 + fr);
        const unsigned voff = (unsigned)((8 * wid) * PROJ_LD + 512 + h * 128 + lane);
        const unsigned goff = (unsigned)((32 * th + fr) * PROJ_LD + 1024 + 4 * fq);
#define GLA_LOAD(n_) do { const bf16_t* Pc = PROJ + (size_t)(row0 + (n_) * 64) * PROJ_LD + 1952; \
        _Pragma("unroll") for (int tti = 0; tti < 2; ++tti) { _Pragma("unroll") for (int i = 0; i < 4; ++i) { const unsigned o = qoff + (unsigned)((16 * tti + i) * PROJ_LD); qraw[4 * tti + i] = Pc[o]; kraw[4 * tti + i] = Pc[o + 256]; } \
            graw[tti] = *(const u32x2*)(Pc + goff + (unsigned)(16 * tti * PROJ_LD)); } \
        _Pragma("unroll") for (int i = 0; i < 8; ++i) { const unsigned o = voff + (unsigned)(i * PROJ_LD); vraw[i] = Pc[o]; vraw[8 + i] = Pc[o + 64]; } } while (0)
        GLA_LOAD(dir ? nch - 1 : 0);
        for (int ci = 0; ci < nch; ++ci) {
            const int n = dir ? nch - 1 - ci : ci; const int crow = row0 + n * 64;
            const u32x2 z2 = (u32x2){0u, 0u};
            float lg[2][4], pre[2][4];
            float run = 0.f;
#pragma unroll
            for (int tti = 0; tti < 2; ++tti) {
                const f32x4 z4 = __builtin_amdgcn_mfma_f32_16x16x32_bf16(mk8(graw[tti], z2), mk8(gb2, z2), (f32x4){0.f, 0.f, 0.f, 0.f}, 0, 0, 0);
#pragma unroll
                for (int i = 0; i < 4; ++i) { const float z = z4[i] + gkb; const float az = fabsf(z); lg[tti][i] = ((z < 0.f ? z : 0.f) - __logf(1.0f + __expf(-az))) * (1.0f / 16.0f); }
                float c0 = lg[tti][0], c1 = c0 + lg[tti][1], c2 = c1 + lg[tti][2], c3 = c2 + lg[tti][3];
                float x = c3;
                { const float y = __shfl_up(x, 16); if (fq >= 1) x += y; }
                { const float y = __shfl_up(x, 32); if (fq >= 2) x += y; }
                const float excl = x - c3 + run;
                pre[tti][0] = c0 + excl; pre[tti][1] = c1 + excl; pre[tti][2] = c2 + excl; pre[tti][3] = c3 + excl;
                run += __shfl(x, 48 + fr);
            }
            if (fq == 0) tot[th * 64 + d0 + fr] = run;
            BAR_LDS();
            const float t0s = tot[d0 + fr], t1s = tot[64 + d0 + fr];
            const float all = t0s + t1s, offp = th ? t0s : 0.f;
            const float eall = __expf(all);
#pragma unroll
            for (int tti = 0; tti < 2; ++tti) {
                float kd[4];
#pragma unroll
                for (int i = 0; i < 4; ++i) {
                    const float pin = pre[tti][i] + offp;
                    const float bb = dir ? (all - pin + lg[tti][i]) : pin;
                    const float q = bf2f(qraw[4 * tti + i]) * 0.125f, k = bf2f(kraw[4 * tti + i]);
                    const float eb = __expf(bb), ieb = __builtin_amdgcn_rcpf(eb);
                    const int t = 32 * th + 16 * tti + 4 * fq + i;
                    Qin[t * SD + d0 + fr] = (bf16_t)f2bf(q * eb);
                    const float kin = k * ieb;
                    Kin[t * SD + d0 + fr] = (bf16_t)f2bf(kin);
                    kd[i] = kin * eall;
                }
                u32x2 w; w.x = pk2(kd[0], kd[1]); w.y = pk2(kd[2], kd[3]); *(LAS u32x2*)(KdT + (d0 + fr) * SD + 32 * th + 16 * tti + 4 * fq) = w;
            }
            { u32x4 w; w.x = vraw[0] | (vraw[1] << 16); w.y = vraw[2] | (vraw[3] << 16); w.z = vraw[4] | (vraw[5] << 16); w.w = vraw[6] | (vraw[7] << 16); *(LAS u32x4*)(VT + lane * SD + 8 * wid) = w; }
            { u32x4 w; w.x = vraw[8] | (vraw[9] << 16); w.y = vraw[10] | (vraw[11] << 16); w.z = vraw[12] | (vraw[13] << 16); w.w = vraw[14] | (vraw[15] << 16); *(LAS u32x4*)(VT + (64 + lane) * SD + 8 * wid) = w; }
            if (th == 0 && fq == 0) bl[d0 + fr] = eall;
            { const int cn = ci + 1 < nch ? ci + 1 : ci; GLA_LOAD(dir ? nch - 1 - cn : cn); }
            BAR_LDS();
            bf16x8 qf[2];
#pragma unroll
            for (int ks = 0; ks < 2; ++ks) qf[ks] = *(const LAS bf16x8*)(Qin + (16 * tt + fr) * SD + 32 * ks + 8 * fq);
            f32x4 accA[4];
#pragma unroll
            for (int st = 0; st < 4; ++st) { accA[st] = (f32x4){0.f, 0.f, 0.f, 0.f};
#pragma unroll
                for (int ks = 0; ks < 2; ++ks) { const bf16x8 kf = *(const LAS bf16x8*)(Kin + (16 * st + fr) * SD + 32 * ks + 8 * fq); accA[st] = __builtin_amdgcn_mfma_f32_16x16x32_bf16(kf, qf[ks], accA[st], 0, 0, 0); } }
            const int tq = 16 * tt + fr;
#pragma unroll
            for (int st = 0; st < 4; ++st)
#pragma unroll
                for (int i = 0; i < 4; ++i) { const int s = 16 * st + 4 * fq + i; const bool keep = dir ? (s >= tq) : (s <= tq); accA[st][i] = keep ? accA[st][i] : 0.f; }
            bf16x8 pf[2];
#pragma unroll
            for (int kb = 0; kb < 2; ++kb) { u32x4 w; w.x = pk2(accA[2 * kb][0], accA[2 * kb][1]); w.y = pk2(accA[2 * kb][2], accA[2 * kb][3]); w.z = pk2(accA[2 * kb + 1][0], accA[2 * kb + 1][1]); w.w = pk2(accA[2 * kb + 1][2], accA[2 * kb + 1][3]); pf[kb] = __builtin_bit_cast(bf16x8, w); }
            f32x4 accO[4];
#pragma unroll
            for (int et = 0; et < 4; ++et) {
                accO[et] = (f32x4){0.f, 0.f, 0.f, 0.f};
                const int E = eh * 64 + 16 * et;
#pragma unroll
                for (int kb = 0; kb < 2; ++kb) {
                    const u32x2 lo = *(const LAS u32x2*)(VT + (E + fr) * SD + 32 * kb + 4 * fq), hi = *(const LAS u32x2*)(VT + (E + fr) * SD + 32 * kb + 16 + 4 * fq);
                    accO[et] = __builtin_amdgcn_mfma_f32_16x16x32_bf16(mk8(lo, hi), pf[kb], accO[et], 0, 0, 0);
                }
#pragma unroll
                for (int ks = 0; ks < 2; ++ks) { const bf16x8 sf = *(const LAS bf16x8*)(STt + (E + fr) * SD + 32 * ks + 8 * fq); accO[et] = __builtin_amdgcn_mfma_f32_16x16x32_bf16(sf, qf[ks], accO[et], 0, 0, 0); }
            }
            const f32x4 dec = *(const LAS f32x4*)(bl + 16 * dt + 4 * fq);
#pragma unroll
            for (int e4 = 0; e4 < 4; ++e4) {
                accS[e4] = accS[e4] * dec;
                const int Et = (etg + e4) * 16;
#pragma unroll
                for (int kb = 0; kb < 2; ++kb) {
                    const bf16x8 kdf = *(const LAS bf16x8*)(KdT + (16 * dt + fr) * SD + 32 * kb + 8 * fq);
                    const bf16x8 vf = *(const LAS bf16x8*)(VT + (Et + fr) * SD + 32 * kb + 8 * fq);
                    accS[e4] = __builtin_amdgcn_mfma_f32_16x16x32_bf16(kdf, vf, accS[e4], 0, 0, 0);
                }
            }
            bf16_t* orow = MIX + (size_t)(crow + tq) * 1024 + 512 + h * 128 + eh * 64 + 4 * fq;
            if (dir == 1) {
#pragma unroll
                for (int et = 0; et < 4; ++et) { const u32x2 w = *(const u32x2*)(orow + 16 * et); accO[et][0] += bflo(w.x); accO[et][1] += bfhi(w.x); accO[et][2] += bflo(w.y); accO[et][3] += bfhi(w.y); }
            }
#pragma unroll
            for (int et = 0; et < 4; ++et) { u32x2 w; w.x = pk2(accO[et][0], accO[et][1]); w.y = pk2(accO[et][2], accO[et][3]); *(u32x2*)(orow + 16 * et) = w; }
            BAR_LDS();
#pragma unroll
            for (int e4 = 0; e4 < 4; ++e4) { u32x2 w; w.x = pk2(accS[e4][0], accS[e4][1]); w.y = pk2(accS[e4][2], accS[e4][3]); *(LAS u32x2*)(STt + ((etg + e4) * 16 + fr) * SD + 16 * dt + 4 * fq) = w; }
        }
#undef GLA_LOAD
    }
}

__device__ __forceinline__ void combine_phase(KA a, int G, const int tid, const int bid) {
    const int wid = tid >> 6, lane = tid & 63;
    unsigned char* ws = AWS;
    const bf16_t* PROJ = (const bf16_t*)(ws + WS_PROJ); const bf16_t* LO = (const bf16_t*)AOUT; const bf16_t* YF = (const bf16_t*)(ws + WS_YF); const bf16_t* YB = (const bf16_t*)(ws + WS_YB);
    const bf16_t* GB = (const bf16_t*)(ws + WS_GB); bf16_t* MIX = (bf16_t*)(ws + WS_MIXED);
    const int gw = bid * 8 + wid, NGW = G * 8;
    const int c0 = 8 * lane;
    float mpr[8], mnr[8], mpk[8], mnk[8], mpv[8], mnv[8], kav[8], rkv[8], lw[8], lb[8];
    ldf8(AIN(I_MU_PREV) + c0, mpr); ldf8(AIN(I_MU_NEXT) + c0, mnr); ldf8(AIN(I_MU_PREV) + 512 + c0, mpk); ldf8(AIN(I_MU_NEXT) + 512 + c0, mnk);
    ldf8(AIN(I_MU_PREV) + 1024 + c0, mpv); ldf8(AIN(I_MU_NEXT) + 1024 + c0, mnv); ldf8(AIN(I_K_A) + c0, kav); ldf8(AIN(I_R_K) + c0, rkv); ldf8(AIN(I_LNX_W) + c0, lw); ldf8(AIN(I_LNX_B) + c0, lb);
    float gnw[8]; ldf8(AIN(I_GLA_NW) + (c0 & 127), gnw);
    for (int t = gw; t < T_ALL; t += NGW) {
        int pos, len; seq_pos(t, pos, len); const bool first = pos == 0, last = pos == len - 1;
        const bf16_t* P = PROJ + (size_t)t * PROJ_LD;
        float r[8], k[8], v[8], af[8], ab[8], yf[8], yb[8], g[8];
        shift8(P, c0, first, last, mpr, mnr, r); shift8(P, 512 + c0, first, last, mpk, mnk, k); shift8(P, 1024 + c0, first, last, mpv, mnv, v);
        ld8nt(LO + (size_t)t * 2048 + 1024 + c0, af); ld8nt(LO + (size_t)t * 2048 + 1536 + c0, ab);
        ld8nt(YF + (size_t)t * 512 + c0, yf); ld8nt(YB + (size_t)t * 512 + c0, yb); ld8nt(GB + (size_t)t * 512 + c0, g);
        float bon = 0.f, sy = 0.f;
#pragma unroll
        for (int j = 0; j < 8; ++j) { bon += r[j] * k[j] * (2.0f + (af[j] + ab[j] - 2.0f) * kav[j]) * rkv[j]; yf[j] += yb[j]; sy += yf[j]; }
        bon += __shfl_xor(bon, 1); sy += __shfl_xor(sy, 1); bon += __shfl_xor(bon, 2); sy += __shfl_xor(sy, 2); bon += __shfl_xor(bon, 4); sy += __shfl_xor(sy, 4);
        const float mean = sy * (1.0f / 64.0f);
        float sv = 0.f;
#pragma unroll
        for (int j = 0; j < 8; ++j) { yf[j] -= mean; sv += yf[j] * yf[j]; }
        sv += __shfl_xor(sv, 1); sv += __shfl_xor(sv, 2); sv += __shfl_xor(sv, 4);
        const float rstd = 1.0f / sqrtf(sv * (1.0f / 64.0f) + 64e-5f);
        float o[8];
#pragma unroll
        for (int j = 0; j < 8; ++j) o[j] = (yf[j] * rstd * lw[j] + lb[j] + bon * v[j]) * g[j];
        *(u32x4*)(MIX + (size_t)t * 1024 + c0) = st8(o);
        float of[8], gg[8];
        ld8nt(MIX + (size_t)t * 1024 + 512 + c0, of); ld8nt(P + 1952 + 1040 + c0, gg);
        float ss = 0.f;
#pragma unroll
        for (int j = 0; j < 8; ++j) ss += of[j] * of[j];
        ss += __shfl_xor(ss, 1); ss += __shfl_xor(ss, 2); ss += __shfl_xor(ss, 4); ss += __shfl_xor(ss, 8);
        const float rsg = 1.0f / sqrtf(ss * (1.0f / 128.0f) + 1e-5f);
#pragma unroll
        for (int j = 0; j < 8; ++j) o[j] = of[j] * rsg * gnw[j] * gg[j] * sigmoidf_(gg[j]);
        *(u32x4*)(MIX + (size_t)t * 1024 + 512 + c0) = st8(o);
    }
}

__device__ __forceinline__ void rowpass_phase(KA a, int G, int which, const int tid, const int bid) {
    const int wid = tid >> 6, lane = tid & 63;
    unsigned char* ws = AWS; float* sm = (float*)(ws + WS_SMALL);
    bf16_t* XBUF = (bf16_t*)(ws + WS_MO);
    const float* ssq = sm + (which == 0 ? OFF_SSQ1 : (which == 1 ? OFF_SSQ2 : OFF_SSQ3));
    const float* gp = AIN(which == 0 ? I_G_MIX_POST : (which == 1 ? I_G_X_POST : I_G_FFN_POST));
    float* rsout = sm + (which == 0 ? OFF_RS1 : OFF_RS2);
    const int gw = bid * 8 + wid, NGW = G * 8;
    f32x4 gv[4];
#pragma unroll
    for (int j = 0; j < 4; ++j) gv[j] = ((const f32x4*)gp)[lane + 64 * j];
    constexpr int NR = 3;
    for (int t0 = gw; t0 < T_ALL; t0 += NR * NGW) {
        int tt[NR]; float sc[NR]; f32x4 bvf[NR][4]; u32x2 bvh[NR][4], brw[NR][4];
#pragma unroll
        for (int q = 0; q < NR; ++q) {
            const int t = t0 + q * NGW < T_ALL ? t0 + q * NGW : t0; tt[q] = t;
            const bf16_t* BRp = which == 0 ? (const bf16_t*)(ws + WS_MO) + (size_t)t * DM : (which == 1 ? (const bf16_t*)(ws + WS_XO) + (size_t)t * DM
                              : (t < FO_SPLIT ? (const bf16_t*)(ws + WS_KB) + (size_t)t * DM : (const bf16_t*)(ws + WS_FO_HI) + (size_t)(t - FO_SPLIT) * DM));
            const u32x2* br = (const u32x2*)BRp + lane;
            const u32x2* xb = (const u32x2*)(XBUF + (size_t)t * DM) + lane;
            const f32x4* basef = (const f32x4*)xrow_ptr(a, t) + lane;
#pragma unroll
            for (int j = 0; j < 4; ++j) { if (which == 0) bvf[q][j] = __builtin_nontemporal_load(basef + 64 * j); else bvh[q][j] = __builtin_nontemporal_load(xb + 64 * j); brw[q][j] = __builtin_nontemporal_load(br + 64 * j); }
            sc[q] = ssq[t];
        }
#pragma unroll
        for (int q = 0; q < NR; ++q) {
            if (q > 0 && tt[q] == t0) continue;
            const int t = tt[q];
            const float scl = 1.0f / sqrtf(sc[q] * (1.0f / DM) + 1e-6f);
            u32x2* xb = (u32x2*)(XBUF + (size_t)t * DM) + lane;
            f32x4* orow = (f32x4*)(AOUT + (size_t)t * DM) + lane;
            f32x4 x[4]; float s = 0.f;
#pragma unroll
            for (int j = 0; j < 4; ++j) {
                f32x4 bv;
                if (which == 0) bv = bvf[q][j]; else { const u32x2 w1 = bvh[q][j]; bv = (f32x4){bflo(w1.x), bfhi(w1.x), bflo(w1.y), bfhi(w1.y)}; }
                const u32x2 w = brw[q][j];
                x[j].x = bv.x + bflo(w.x) * scl * gv[j].x; x[j].y = bv.y + bfhi(w.x) * scl * gv[j].y; x[j].z = bv.z + bflo(w.y) * scl * gv[j].z; x[j].w = bv.w + bfhi(w.y) * scl * gv[j].w;
                s += (x[j].x * x[j].x + x[j].y * x[j].y) + (x[j].z * x[j].z + x[j].w * x[j].w);
            }
            if (which == 2) {
#pragma unroll
                for (int j = 0; j < 4; ++j) __builtin_nontemporal_store(x[j], orow + 64 * j);
            } else {
                s = wave_sum(s);
#pragma unroll
                for (int j = 0; j < 4; ++j) { u32x2 w; w.x = pk2(x[j].x, x[j].y); w.y = pk2(x[j].z, x[j].w); xb[64 * j] = w; }
                if (lane == 0) rsout[t] = 1.0f / sqrtf(s * (1.0f / DM) + 1e-6f);
            }
        }
    }
}

__device__ __forceinline__ void xattn_phase(KA a, LAS unsigned char* lds, int G, const int tid, const int bid) {
    const int wid = __builtin_amdgcn_readfirstlane(tid >> 6), lane = tid & 63, fr = lane & 15, fq = lane >> 4;
    unsigned char* ws = AWS;
    const bf16_t* Q = (const bf16_t*)(ws + WS_Q); const bf16_t* KB = (const bf16_t*)(ws + WS_KB); const bf16_t* VTg = (const bf16_t*)(ws + WS_VT); bf16_t* OB = (bf16_t*)(ws + WS_OB);
    constexpr int KS = 264, VS = 68;
    LAS bf16_t* Ks = (LAS bf16_t*)lds;
    LAS bf16_t* Vs = Ks + 64 * KS;
    u32x4 stg[4];
#define XA_FETCH(u_, s_) do { const int qt_ = (u_) >> 2, h_ = (u_) & 3, r0_ = qt_ * 128; const int bi_ = r0_ < TP ? r0_ / 2048 : 8 + (r0_ - TP) / 4096; \
        if ((s_) < 4) { _Pragma("unroll") for (int i = 0; i < 4; ++i) { const int cidx = tid + 512 * i, r = cidx >> 5, c8 = cidx & 31; stg[i] = *(const u32x4*)(KB + (size_t)(bi_ * 256 + (s_) * 64 + r) * 1024 + h_ * 256 + c8 * 8); } } \
        else { _Pragma("unroll") for (int i = 0; i < 4; ++i) { const int cidx = tid + 512 * i, r = cidx >> 3, c8 = cidx & 7; stg[i] = *(const u32x4*)(VTg + (size_t)(h_ * 256 + r) * TM + bi_ * 256 + ((s_) - 4) * 64 + c8 * 8); } } } while (0)
#define XA_PUT_K() do { _Pragma("unroll") for (int i = 0; i < 4; ++i) { const int cidx = tid + 512 * i, r = cidx >> 5, c8 = cidx & 31; *(LAS u32x4*)(Ks + r * KS + c8 * 8) = stg[i]; } } while (0)
#define XA_PUT_V() do { _Pragma("unroll") for (int i = 0; i < 4; ++i) { const int cidx = tid + 512 * i, r = cidx >> 3, c8 = cidx & 7; *(LAS u32x2*)(Vs + r * VS + c8 * 8) = (u32x2){stg[i].x, stg[i].y}; *(LAS u32x2*)(Vs + r * VS + c8 * 8 + 4) = (u32x2){stg[i].z, stg[i].w}; } } while (0)
    if (bid < 2560) XA_FETCH(bid, 0);
    for (int u = bid; u < 2560; u += G) {
        const int qt = u >> 2, h = u & 3, row0 = qt * 128;
        const int qrow = row0 + 16 * wid + fr;
        bf16x8 qf[8];
#pragma unroll
        for (int ks = 0; ks < 8; ++ks) qf[ks] = __builtin_nontemporal_load((const bf16x8*)(Q + (size_t)qrow * 1024 + h * 256 + 32 * ks + 8 * fq));
        f32x4 accS[16];
#pragma unroll
        for (int n = 0; n < 16; ++n) accS[n] = (f32x4){0.f, 0.f, 0.f, 0.f};
#pragma unroll
        for (int kt = 0; kt < 4; ++kt) {
            BAR_LDS();
            XA_PUT_K();
            XA_FETCH(u, kt + 1);
            BAR_LDS();
#pragma unroll
            for (int n = 0; n < 4; ++n)
#pragma unroll
                for (int ks = 0; ks < 8; ++ks) { const bf16x8 kf = *(const LAS bf16x8*)(Ks + (16 * n + fr) * KS + 32 * ks + 8 * fq); accS[kt * 4 + n] = __builtin_amdgcn_mfma_f32_16x16x32_bf16(kf, qf[ks], accS[kt * 4 + n], 0, 0, 0); }
        }
        float mx = -3.0e38f;
#pragma unroll
        for (int n = 0; n < 16; ++n)
#pragma unroll
            for (int i = 0; i < 4; ++i) mx = fmaxf(mx, accS[n][i]);
        mx = fmaxf(mx, __shfl_xor(mx, 16)); mx = fmaxf(mx, __shfl_xor(mx, 32));
        float sum = 0.f;
#pragma unroll
        for (int n = 0; n < 16; ++n)
#pragma unroll
            for (int i = 0; i < 4; ++i) { const float p = __expf(accS[n][i] - mx); accS[n][i] = p; sum += p; }
        sum += __shfl_xor(sum, 16); sum += __shfl_xor(sum, 32);
        const float inv = 1.0f / sum;
        bf16x8 pf[8];
#pragma unroll
        for (int kb = 0; kb < 8; ++kb) { u32x4 w; w.x = pk2(accS[2 * kb][0], accS[2 * kb][1]); w.y = pk2(accS[2 * kb][2], accS[2 * kb][3]); w.z = pk2(accS[2 * kb + 1][0], accS[2 * kb + 1][1]); w.w = pk2(accS[2 * kb + 1][2], accS[2 * kb + 1][3]); pf[kb] = __builtin_bit_cast(bf16x8, w); }
        f32x4 accO[16];
#pragma unroll
        for (int n = 0; n < 16; ++n) accO[n] = (f32x4){0.f, 0.f, 0.f, 0.f};
        const int un = u + G;
#pragma unroll
        for (int k4 = 0; k4 < 4; ++k4) {
            BAR_LDS();
            XA_PUT_V();
            if (k4 < 3) XA_FETCH(u, 5 + k4); else if (un < 2560) XA_FETCH(un, 0);
            BAR_LDS();
#pragma unroll
            for (int kb = 0; kb < 2; ++kb)
#pragma unroll
                for (int dtile = 0; dtile < 16; ++dtile) {
                    const u32x2 lo = *(const LAS u32x2*)(Vs + (16 * dtile + fr) * VS + 32 * kb + 4 * fq), hi = *(const LAS u32x2*)(Vs + (16 * dtile + fr) * VS + 32 * kb + 16 + 4 * fq);
                    accO[dtile] = __builtin_amdgcn_mfma_f32_16x16x32_bf16(mk8(lo, hi), pf[k4 * 2 + kb], accO[dtile], 0, 0, 0);
                }
        }
        bf16_t* orow = OB + (size_t)qrow * 1024 + h * 256 + 4 * fq;
#pragma unroll
        for (int dtile = 0; dtile < 16; ++dtile) { u32x2 w; w.x = pk2(accO[dtile][0] * inv, accO[dtile][1] * inv); w.y = pk2(accO[dtile][2] * inv, accO[dtile][3] * inv); *(u32x2*)(orow + 16 * dtile) = w; }
    }
#undef XA_FETCH
#undef XA_PUT_K
#undef XA_PUT_V
}

#define XB_TMO      128
#define XB_XCNT(j)  (256  + 64 * (j))
#define XB_XSUB(j)  (1280 + 64 * (j))
#define XB_XGEN(j)  (2304 + 64 * (j))
#define XB_TOP      3328
#define XB_TOPGEN   3392
#define XB_SPIN_CAP (1u << 22)
__device__ __forceinline__ unsigned xb_ld(unsigned* p)              { return __hip_atomic_load(p, __ATOMIC_RELAXED, __HIP_MEMORY_SCOPE_AGENT); }
__device__ __forceinline__ unsigned xb_add(unsigned* p, unsigned v) { return __hip_atomic_fetch_add(p, v, __ATOMIC_RELAXED, __HIP_MEMORY_SCOPE_AGENT); }
__device__ __forceinline__ unsigned xb_xcc_id() { return (unsigned)__builtin_amdgcn_s_getreg((3 << 11) | 20) & 0xFu; }
#define XB_SPIN(cond, bar) do { unsigned _sp = 0; while (cond) { __builtin_amdgcn_s_sleep(1); \
    if ((++_sp & 255u) == 0u) { if (xb_ld(&(bar)[XB_TMO])) break; if (_sp > XB_SPIN_CAP) { atomicAdd(&(bar)[XB_TMO], 1u); break; } } } } while (0)
struct XcdBarrier { unsigned* bar; unsigned x; volatile LAS unsigned* st; };
__device__ __forceinline__ XcdBarrier xcd_barrier_post(unsigned* bar, volatile LAS unsigned* st, int tid) {
    XcdBarrier b; b.bar = bar; b.x = xb_xcc_id(); b.st = st;
    if (tid == 0) (void)xb_add(&bar[XB_XCNT(b.x)], 1u);
    return b;
}
__device__ __forceinline__ void xcd_barrier_complete(unsigned* bar, unsigned x, unsigned G, unsigned& nloc, unsigned& nx) {
    unsigned sum, cnt, mine, sp = 0u;
    for (;;) {
        sum = 0u; cnt = 0u; mine = 0u;
#pragma unroll
        for (unsigned j = 0; j < 16; ++j) { const unsigned c = xb_ld(&bar[XB_XCNT(j)]); sum += c; cnt += (c > 0u) ? 1u : 0u; mine = (j == x) ? c : mine; }
        if (sum == G) break;
        __builtin_amdgcn_s_sleep(1);
        if ((++sp & 255u) == 0u) { if (xb_ld(&bar[XB_TMO])) break; if (sp > XB_SPIN_CAP) { atomicAdd(&bar[XB_TMO], 1u); break; } }
    }
    nloc = mine > 0u ? mine : 1u; nx = cnt > 0u ? cnt : 1u;
}
__device__ __forceinline__ void xcd_barrier(const XcdBarrier& b, int tid, unsigned G) {
    asm volatile("s_waitcnt vmcnt(0)" ::: "memory");
    __syncthreads();
    if (tid == 0) {
        unsigned* bar = b.bar;
        __builtin_amdgcn_s_waitcnt(0);
        unsigned nloc = b.st[0], nx = b.st[1];
        if (nloc == 0u) { xcd_barrier_complete(bar, b.x, G, nloc, nx); b.st[0] = nloc; b.st[1] = nx; }
        const unsigned old = xb_add(&bar[XB_XSUB(b.x)], 1u);
        const unsigned gen = old / nloc;
        if (old + 1u == (gen + 1u) * nloc) {
            __builtin_amdgcn_fence(__ATOMIC_RELEASE, "agent");
            asm volatile("s_waitcnt vmcnt(0)" ::: "memory");
            const unsigned og = xb_add(&bar[XB_TOP], 1u);
            const unsigned tg = og / nx;
            if (og + 1u == (tg + 1u) * nx) xb_add(&bar[XB_TOPGEN], 1u);
            else XB_SPIN(xb_ld(&bar[XB_TOPGEN]) == tg, bar);
            __builtin_amdgcn_fence(__ATOMIC_ACQUIRE, "agent");
            xb_add(&bar[XB_XGEN(b.x)], 1u);
            asm volatile("s_waitcnt vmcnt(0)" ::: "memory");
        } else {
            XB_SPIN(xb_ld(&bar[XB_XGEN(b.x)]) == gen, bar);
            __builtin_amdgcn_fence(__ATOMIC_ACQUIRE, "agent");
            asm volatile("s_waitcnt vmcnt(0)" ::: "memory");
        }
    }
    __syncthreads();
}

__device__ __forceinline__ void build_gemm(KA a, int gi, pg8::Gemm& g) {
    unsigned char* ws = AWS;
    switch (gi) {
    case 0: g = pg8::Gemm{(const bf16_t*)(ws + WS_XB), (const bf16_t*)(ws + WS_WIN), T_ALL, 3584, 1024, 1024, 1024}; break;
    case 1: g = pg8::Gemm{(const bf16_t*)(ws + WS_MEMB), (const bf16_t*)(ws + WS_WKV), TM, 1024, 1024, 1024, 1024}; break;
    case 2: g = pg8::Gemm{(const bf16_t*)(ws + WS_WKV) + (size_t)1024 * 1024, (const bf16_t*)(ws + WS_MEMB), 1024, TM, 1024, 1024, 1024}; break;
    case 3: g = pg8::Gemm{(const bf16_t*)(ws + WS_AL), (const bf16_t*)(ws + WS_WL), T_ALL, 2048, 256, 512, 512}; break;
    case 9: g = pg8::Gemm{(const bf16_t*)(ws + WS_AL) + 256, (const bf16_t*)(ws + WS_WL) + (size_t)2048 * 512 + 256, T_ALL, 512, 256, 512, 512}; break;
    case 4: g = pg8::Gemm{(const bf16_t*)(ws + WS_MIXED), (const bf16_t*)(ws + WS_WOUT), T_ALL, 1024, 1024, 1024, 1024}; break;
    case 5: g = pg8::Gemm{(const bf16_t*)(ws + WS_MO), (const bf16_t*)(ws + WS_WQ), T_ALL, 1024, 1024, 1024, 1024}; break;
    case 6: g = pg8::Gemm{(const bf16_t*)(ws + WS_OB), (const bf16_t*)(ws + WS_WO), T_ALL, 1024, 1024, 1024, 1024}; break;
    case 7: g = pg8::Gemm{(const bf16_t*)(ws + WS_MO), (const bf16_t*)(ws + WS_W1), T_ALL, 4096, 1024, 1024, 1024}; break;
    default: g = pg8::Gemm{(const bf16_t*)(ws + WS_HID), (const bf16_t*)(ws + WS_W2), T_ALL, 1024, 4096, 4096, 4096}; break;
    }
}

__global__ void __launch_bounds__(512, 2) fwd_kernel(Args args_unused) {
    extern __shared__ __attribute__((aligned(16))) unsigned char lds_raw[];
    LAS unsigned char* lds = (LAS unsigned char*)lds_raw;
    cg::grid_group grid = cg::this_grid();
    KA a0 = (KA)__builtin_amdgcn_kernarg_segment_ptr();
    const int ph_lo = a0->ph_lo, ph_hi = a0->ph_hi;
    volatile LAS unsigned* xst = (volatile LAS unsigned*)(lds + 131072);
    if (threadIdx.x < 2) xst[threadIdx.x] = 0u;
    __syncthreads();
    unsigned* barw = (unsigned*)((unsigned char*)a0->ws);
    XcdBarrier xb; xb.bar = barw; xb.x = 0; xb.st = xst;
    for (int ph = ph_lo; ph < ph_hi; ++ph) {
        if (ph == 5 && SCAN_V == 2) continue;
        if (ph > ph_lo) {
            if (ph_lo == 0 && ph > 1) xcd_barrier(xb, threadIdx.x, gridDim.x);
            else { grid.sync(); if (ph_lo == 0) xb = xcd_barrier_post(barw, xst, threadIdx.x); }
        }
        KA a = (KA)__builtin_amdgcn_kernarg_segment_ptr();
        int tid = threadIdx.x, bid = blockIdx.x, G = gridDim.x;
        asm volatile("" : "+s"(a), "+v"(tid), "+s"(bid), "+s"(G));
        int g0 = 0, g1 = 0, gx = -1;
        switch (ph) {
        case 0: if (EN(0)) p0_phase(a, lds, G, tid, bid); if (DUP_PHASE == 0 || DUP_PHASE == 100) { __syncthreads(); p0_phase(a, lds, G, tid, bid); } break;
        case 1: g0 = 0; g1 = 3; break;
        case 2: if (EN(2)) p2_phase(a, G, tid, bid); if (DUP_PHASE == 2 || DUP_PHASE == 100) { __syncthreads(); p2_phase(a, G, tid, bid); } break;
        case 3: g0 = 3; g1 = 4; gx = 9; break;
        case 4: if (EN(4)) { if (SCAN_V == 1) scan_phase(a, lds, G, tid, bid); else if (bid < 160) scan2_phase(a, lds, G, tid, bid); else gla_phase(a, lds, G, tid, bid); }
                if (DUP_PHASE == 41 && bid < 160) { __syncthreads(); scan2_phase(a, lds, G, tid, bid); }
                if (DUP_PHASE == 42 && bid >= 160) { __syncthreads(); gla_phase(a, lds, G, tid, bid); } break;
        case 5: if (EN(5) && SCAN_V == 1) gla_phase(a, lds, G, tid, bid); break;
        case 6: if (EN(6)) combine_phase(a, G, tid, bid); if (DUP_PHASE == 6 || DUP_PHASE == 100) { __syncthreads(); combine_phase(a, G, tid, bid); } break;
        case 7: g0 = 4; g1 = 5; break;
        case 8: if (EN(8)) rowpass_phase(a, G, 0, tid, bid); break;
        case 9: g0 = 5; g1 = 6; break;
        case 10: if (EN(10)) xattn_phase(a, lds, G, tid, bid); if (DUP_PHASE == 10) { __syncthreads(); xattn_phase(a, lds, G, tid, bid); } break;
        case 11: g0 = 6; g1 = 7; break;
        case 12: if (EN(8)) rowpass_phase(a, G, 1, tid, bid); break;
        case 13: g0 = 7; g1 = 8; break;
        case 14: g0 = 8; g1 = 9; break;
        default: if (EN(8)) rowpass_phase(a, G, 2, tid, bid); if (DUP_PHASE == 15) { __syncthreads(); rowpass_phase(a, G, 2, tid, bid); } break;
        }
        if (EN(1)) for (int rep = 0; rep < ((DUP_PHASE == ph && g1 > g0) ? 2 : 1); ++rep) for (int gq = g0; gq < g1 + (gx >= 0 ? 1 : 0); ++gq) {
            const int gi = gq < g1 ? gq : gx;
            pg8::Gemm g; build_gemm(a, gi, g); pg8::EpiD E{gi};
            pg8::StaticOrder S; S.init(g.M, g.N, G, (gi == 1 || gi == 2) ? (G - 1 - bid) : bid);
            __syncthreads();
            pg8::gemm_phase(lds, g, S, E, tid);
        }
    }
}

extern "C" void kernel_launch(void* const* d_in, const int* in_sizes, int n_in, void* d_out, int out_size, void* d_ws, size_t ws_size, hipStream_t stream) {
    static int grid = 0;
    if (grid == 0) {
        int dev = 0, cus = 0, per_cu = 0;
        (void)hipGetDevice(&dev);
        (void)hipDeviceGetAttribute(&cus, hipDeviceAttributeMultiprocessorCount, dev);
        if (hipFuncSetAttribute((const void*)fwd_kernel, hipFuncAttributeMaxDynamicSharedMemorySize, LDS_BYTES) != hipSuccess) { fprintf(stderr, "hipFuncSetAttribute failed\n"); }
        if (hipOccupancyMaxActiveBlocksPerMultiprocessor(&per_cu, (const void*)fwd_kernel, 512, LDS_BYTES) != hipSuccess || per_cu < 1) per_cu = 1;
        (void)hipGetLastError();
        grid = cus * per_cu;
        if (grid > 256) grid = 256;
        if (grid < 1) grid = 256;
    }
    Args a{};
    for (int i = 0; i < 39; ++i) a.in[i] = (const float*)d_in[i];
    a.out = (float*)d_out; a.ws = (unsigned char*)d_ws;
#if MULTI_LAUNCH
    for (int ph = 0; ph < NPH; ++ph) {
        a.ph_lo = ph; a.ph_hi = ph + 1;
        void* args[] = {&a};
        hipError_t e = hipLaunchCooperativeKernel((const void*)fwd_kernel, dim3(grid), dim3(512), args, LDS_BYTES, stream);
        if (e != hipSuccess) { fprintf(stderr, "cooperative launch failed: %s (grid %d)\n", hipGetErrorString(e), grid); break; }
    }
#else
    a.ph_lo = 0; a.ph_hi = NPH;
    void* args[] = {&a};
    hipError_t e = hipLaunchCooperativeKernel((const void*)fwd_kernel, dim3(grid), dim3(512), args, LDS_BYTES, stream);
    if (e != hipSuccess) fprintf(stderr, "cooperative launch failed: %s (grid %d)\n", hipGetErrorString(e), grid);
#endif
}
```

```cpp
#include <hip/hip_runtime.h>
#include <hip/hip_cooperative_groups.h>
#include <cstdio>
namespace cg = cooperative_groups;

#ifndef ONLY
#define ONLY -1
#endif
#define EN(k) (ONLY < 0 || ONLY == (k))
#ifndef SCAN_V
#define SCAN_V 2
#endif
#ifndef DUP_PHASE
#define DUP_PHASE -1
#endif
#ifndef MULTI_LAUNCH
#define MULTI_LAUNCH 0
#endif

#define LAS __attribute__((address_space(3)))
typedef unsigned short bf16_t;
typedef short bf16x8 __attribute__((ext_vector_type(8)));
typedef float f32x4 __attribute__((ext_vector_type(4)));
typedef float f32x2 __attribute__((ext_vector_type(2)));
typedef unsigned u32x4 __attribute__((ext_vector_type(4)));
typedef unsigned u32x2 __attribute__((ext_vector_type(2)));

constexpr int T_ALL = 81920, TP = 16384, TM = 6144, DM = 1024, PROJ_LD = 3504, NPH = 16;
constexpr size_t MiB = 1u << 20;
constexpr size_t WS_SMALL = 1 * MiB;
constexpr int OFF_RS0 = 0, OFF_RSM = T_ALL, OFF_SSQ1 = T_ALL + 8192, OFF_SSQ2 = OFF_SSQ1 + T_ALL, OFF_SSQ3 = OFF_SSQ2 + T_ALL,
              OFF_RS1 = OFF_SSQ3 + T_ALL, OFF_RS2 = OFF_RS1 + T_ALL, OFF_KSC = OFF_RS2 + T_ALL;
constexpr size_t WS_WIN = 8 * MiB, WS_WOUT = 15 * MiB, WS_WQ = 17 * MiB, WS_WKV = 19 * MiB, WS_WO = 23 * MiB, WS_W1 = 25 * MiB, WS_W2 = 33 * MiB, WS_WL = 41 * MiB;
constexpr size_t WS_KB = 44 * MiB, WS_VT = 56 * MiB;
constexpr size_t WS_PROJ = 72 * MiB;
constexpr size_t WS_XB = 620 * MiB, WS_MEMB = 780 * MiB, WS_AL = 620 * MiB, WS_YF = 620 * MiB, WS_GB = 700 * MiB, WS_YB = 780 * MiB, WS_MIXED = 860 * MiB;
constexpr size_t WS_MO = 72 * MiB, WS_Q = 232 * MiB, WS_OB = 392 * MiB, WS_XO = 552 * MiB, WS_HID = 232 * MiB;
constexpr size_t WS_FO_HI = 872 * MiB; constexpr int FO_SPLIT = 4096;
constexpr int LDS_BYTES = 131072 + 256;
#define XCD_BAR_WORDS 3456


typedef __bf16 bf16x2_t __attribute__((ext_vector_type(2)));
__device__ __forceinline__ unsigned pk2(float lo, float hi) { const f32x2 v = {lo, hi}; return __builtin_bit_cast(unsigned, __builtin_convertvector(v, bf16x2_t)); }
__device__ __forceinline__ unsigned f2bf(float f) { return pk2(f, f) & 0xffffu; }
__device__ __forceinline__ float bf2f(unsigned b) { return __builtin_bit_cast(float, (b & 0xffffu) << 16); }
__device__ __forceinline__ float bflo(unsigned w) { return __builtin_bit_cast(float, w << 16); }
__device__ __forceinline__ float bfhi(unsigned w) { return __builtin_bit_cast(float, w & 0xffff0000u); }
__device__ __forceinline__ float wave_sum(float v) {
#pragma unroll
    for (int o = 1; o < 64; o <<= 1) v += __shfl_xor(v, o);
    return v;
}
__device__ __forceinline__ bf16x8 mk8(u32x2 lo, u32x2 hi) { u32x4 w; w.x = lo.x; w.y = lo.y; w.z = hi.x; w.w = hi.y; return __builtin_bit_cast(bf16x8, w); }
__device__ __forceinline__ float sigmoidf_(float z) { return __builtin_amdgcn_rcpf(1.0f + __expf(-z)); }
#define LDS_WAIT() asm volatile("s_waitcnt lgkmcnt(0)" ::: "memory")
#define BAR_LDS() do { asm volatile("s_waitcnt lgkmcnt(0)" ::: "memory"); __builtin_amdgcn_s_barrier(); asm volatile("" ::: "memory"); } while (0)

struct Args { const float* in[39]; float* out; unsigned char* ws; int ph_lo, ph_hi; };
#define GAS __attribute__((address_space(1)))
struct DArgs { const GAS float* in[39]; GAS float* out; GAS unsigned char* ws; int ph_lo, ph_hi; };
typedef const __attribute__((address_space(4))) DArgs* KA;
#define AIN(i) ((const float*)a->in[i])
#define AOUT ((float*)a->out)
#define AWS ((unsigned char*)a->ws)
enum { I_XP = 0, I_XS, I_MP, I_MS, I_G_MIX_PRE, I_W_IN, I_MU_PREV, I_MU_NEXT, I_W0_F, I_W2_F, I_W0_B, I_W2_B, I_A0_F, I_A2_F, I_A0_B, I_A2_B, I_G2, I_K_K, I_K_A, I_R_K,
       I_LNX_W, I_LNX_B, I_GK2_F, I_GKB_F, I_GK2_B, I_GKB_B, I_GLA_NW, I_W_OUT, I_G_MIX_POST, I_G_X_PRE, I_G_MEM, I_WQ, I_WKV, I_WO, I_G_X_POST, I_G_FFN_PRE, I_W_FF1, I_W_FF2, I_G_FFN_POST };

namespace pg8 {
constexpr int BM = 256, BK = 64, HALF = 128, HTB = HALF * BK * 2, STAGE_BYTES = 8 * HTB, NXCD = 8, WGM = 8;
__device__ __forceinline__ int lds_byte(int r, int c) { const int st = (r >> 4) * 2 + (c >> 5), rr = r & 15, cc = c & 31, ob = rr * 64 + cc * 2; return st * 1024 + (ob ^ (((ob >> 9) & 1) << 5)); }
__device__ __forceinline__ void stage_rc(int b, int& R, int& C) { const int st = b / 1024, sb = b % 1024, swz = sb ^ (((sb >> 9) & 1) << 5); R = (st >> 1) * 16 + swz / 64; C = (st & 1) * 32 + (swz % 64) / 2; }
__device__ __forceinline__ int perm32(int rho) { const int n = rho >> 4, i = rho & 15; return 8 * (i >> 2) + 4 * n + (i & 3); }
struct Unit { int pm, pn; };
struct Gemm { const bf16_t* A; const bf16_t* Bt; int M, N, K, lda, ldb; };
struct StaticOrder {
    int nM, nN, nwg, G, c;
    __device__ void init(int M, int N, int G_, int c_) { nM = M / BM; nN = N / BM; nwg = nM * nN; G = G_; c = c_; }
    __device__ bool next(int i, Unit& u) const {
        const long L = (long)i * G + c; if (L >= nwg) return false;
        int wgid = (int)L; { const int q = nwg / NXCD, r = nwg % NXCD, xcd = wgid % NXCD, off = wgid / NXCD; wgid = (xcd < r ? xcd * (q + 1) : r * (q + 1) + (xcd - r) * q) + off; }
        const int nig = WGM * nN, gid = wgid / nig, fm = gid * WGM, gsz = (nM - fm) < WGM ? (nM - fm) : WGM;
        u.pm = fm + ((wgid % nig) % gsz); u.pn = (wgid % nig) / gsz; return true;
    }
};

struct EpiP {
    bf16_t* O; int ldc, ncols; const float* rowscale; const float* colscale; float scal; float* ssq; int act;
    bf16_t* O2; const float* b0; const float* b1; const float* b2; const float* b3;
    bf16_t* Olo; int split;
};
__device__ __forceinline__ void build_epi(KA a, int gi, EpiP& E) {
    unsigned char* ws = AWS; float* sm = (float*)(ws + WS_SMALL);
    E.O = nullptr; E.ldc = 1024; E.ncols = 1 << 30; E.rowscale = nullptr; E.colscale = nullptr; E.scal = 1.0f; E.ssq = nullptr; E.act = 0; E.O2 = nullptr; E.b0 = E.b1 = E.b2 = E.b3 = nullptr; E.Olo = nullptr; E.split = 0;
    switch (gi) {
    case 0: E.O = (bf16_t*)(ws + WS_PROJ); E.ldc = PROJ_LD; E.ncols = PROJ_LD; E.rowscale = sm + OFF_RS0; break;
    case 1: E.O = (bf16_t*)(ws + WS_KB); E.ldc = 1024; E.rowscale = sm + OFF_RSM; break;
    case 2: E.O = (bf16_t*)(ws + WS_VT); E.ldc = TM; E.colscale = sm + OFF_RSM; break;
    case 3: E.O = (bf16_t*)AOUT; E.ldc = 2048; E.act = 2; E.O2 = (bf16_t*)(ws + WS_GB); E.b0 = AIN(I_W0_F); E.b1 = AIN(I_W0_B); E.b2 = AIN(I_A0_F); E.b3 = AIN(I_A0_B); break;
    case 9: E.O = (bf16_t*)(ws + WS_GB); E.ldc = 512; break;
    case 4: E.O = (bf16_t*)(ws + WS_MO); E.ssq = sm + OFF_SSQ1; break;
    case 5: E.O = (bf16_t*)(ws + WS_Q); E.rowscale = sm + OFF_RS1; E.scal = 0.0625f; break;
    case 6: E.O = (bf16_t*)(ws + WS_XO); E.ssq = sm + OFF_SSQ2; break;
    case 7: E.O = (bf16_t*)(ws + WS_HID); E.ldc = 4096; E.rowscale = sm + OFF_RS2; E.act = 1; break;
    default: E.O = (bf16_t*)(ws + WS_FO_HI) - (size_t)FO_SPLIT * 1024; E.Olo = (bf16_t*)(ws + WS_KB); E.split = FO_SPLIT; E.ssq = sm + OFF_SSQ3; break;
    }
}
struct EpiD {
    static constexpr bool PERM = true;
    int gi;
    __device__ __forceinline__ void operator()(const f32x4 (&acc)[2][2][4][2], const Unit& u, int wr, int wc, int fr, int fq) const {
        KA a = (KA)__builtin_amdgcn_kernarg_segment_ptr();
        int gl = gi; asm volatile("" : "+s"(gl), "+s"(a));
        EpiP P; build_epi(a, gl, P);
        const int colbase = u.pn * BM + wc * 32 + 8 * fq;
        const int grp = u.pn >> 1;
        const float* bias = grp == 0 ? P.b0 : (grp == 1 ? P.b1 : (grp == 2 ? P.b2 : P.b3));
#pragma unroll
        for (int ai = 0; ai < 2; ++ai)
#pragma unroll
            for (int m = 0; m < 4; ++m) {
                const int row = u.pm * BM + ai * HALF + wr * 64 + m * 16 + fr;
                const float rsc = P.rowscale ? P.scal * P.rowscale[row] : P.scal;
                float ss = 0.f;
#pragma unroll
                for (int bj = 0; bj < 2; ++bj) {
                    const int col = colbase + bj * HALF;
                    f32x4 v0 = acc[ai][bj][m][0] * rsc, v1 = acc[ai][bj][m][1] * rsc;
                    if (P.colscale) { const f32x4 c0 = *(const f32x4*)(P.colscale + col), c1 = *(const f32x4*)(P.colscale + col + 4); v0 = v0 * c0; v1 = v1 * c1; }
                    if (P.act == 1) {
#pragma unroll
                        for (int j = 0; j < 4; ++j) { const float a0 = v0[j] > 0.f ? v0[j] : 0.f, a1 = v1[j] > 0.f ? v1[j] : 0.f; v0[j] = a0 * a0; v1[j] = a1 * a1; }
                    }
                    bf16_t* dst = (row < P.split ? P.Olo : P.O) + (size_t)row * P.ldc + col;
                    if (P.act == 2) {
                        if (grp < 4) {
                            const int bc = col - grp * 512;
                            const f32x4 c0 = *(const f32x4*)(bias + bc), c1 = *(const f32x4*)(bias + bc + 4);
                            const float mul = grp < 2 ? -0.60653066f : 1.0f;
#pragma unroll
                            for (int j = 0; j < 4; ++j) { v0[j] = mul * sigmoidf_(v0[j] + c0[j]); v1[j] = mul * sigmoidf_(v1[j] + c1[j]); }
                        } else dst = P.O2 + (size_t)row * 512 + (col - 2048);
                    }
                    if (P.ssq) ss += (v0[0] * v0[0] + v0[1] * v0[1]) + (v0[2] * v0[2] + v0[3] * v0[3]) + (v1[0] * v1[0] + v1[1] * v1[1]) + (v1[2] * v1[2] + v1[3] * v1[3]);
                    if (col < P.ncols) { u32x4 w; w.x = pk2(v0[0], v0[1]); w.y = pk2(v0[2], v0[3]); w.z = pk2(v1[0], v1[1]); w.w = pk2(v1[2], v1[3]);
                        if (P.ldc >= 3504) __builtin_nontemporal_store(w, (u32x4*)dst); else *(u32x4*)dst = w; }
                }
                if (P.ssq) { ss += __shfl_xor(ss, 16); ss += __shfl_xor(ss, 32); if (fq == 0) atomicAdd(P.ssq + row, ss); }
            }
    }
};

__device__ __forceinline__ void gemm_phase(LAS unsigned char* lds, const Gemm g, const StaticOrder& S, const EpiD& E, const int tid) {
    const int wid = __builtin_amdgcn_readfirstlane(tid >> 6), lane = tid & 63, wr = wid >> 2, wc = wid & 3, fr = lane & 15, fq = lane >> 4;
    const int K = g.K, nt = K / BK;
    unsigned voffA[2], voffB[2];
#pragma unroll
    for (int i = 0; i < 2; ++i) { int R, C; stage_rc(tid * 16 + i * 8192, R, C); const int Rb = EpiD::PERM ? ((R & ~31) + perm32(R & 31)) : R;
        voffA[i] = (unsigned)(R * g.lda + C) * 2u; voffB[i] = (unsigned)(Rb * g.ldb + C) * 2u; }
    const size_t kstep = (size_t)(BK * 2);
    const size_t hstepA = (size_t)HALF * g.lda * 2, hstepB = (size_t)HALF * g.ldb * 2;
    const size_t tstepA = 2 * hstepA, tstepB = 2 * hstepB;
    const unsigned ldsw = (unsigned)wid * 1024u;
    const int aoff = lds_byte(wr * 64 + fr, fq * 8), boff = lds_byte(wc * 32 + fr, fq * 8);
#define PG8_SA(b, h) (((b) * 2 + (h)) * HTB)
#define PG8_SB(b, h) ((4 + (b) * 2 + (h)) * HTB)
#define PG8_STAGE(bufoff, gbase, voff) do { _Pragma("unroll") for (int _i = 0; _i < 2; ++_i) \
        __builtin_amdgcn_global_load_lds((const unsigned*)((const char*)(gbase) + (voff)[_i]), (LAS unsigned*)(lds + (bufoff) + ldsw + _i * 8192), 16, 0, 0); } while (0)
#define PG8_LDA(dst, b, h) do { _Pragma("unroll") for (int m = 0; m < 4; ++m) _Pragma("unroll") for (int k = 0; k < 2; ++k) dst[m][k] = *(const LAS bf16x8*)(lds + PG8_SA(b, h) + aoff + m * 2048 + k * 1024); } while (0)
#define PG8_LDB(dst, b, h) do { _Pragma("unroll") for (int n = 0; n < 2; ++n) _Pragma("unroll") for (int k = 0; k < 2; ++k) dst[n][k] = *(const LAS bf16x8*)(lds + PG8_SB(b, h) + boff + n * 2048 + k * 1024); } while (0)
#define PG8_MMA(ai, bj, At, Bt) do { __builtin_amdgcn_s_setprio(1); _Pragma("unroll") for (int m = 0; m < 4; ++m) _Pragma("unroll") for (int n = 0; n < 2; ++n) _Pragma("unroll") for (int k = 0; k < 2; ++k) \
        acc[ai][bj][m][n] = __builtin_amdgcn_mfma_f32_16x16x32_bf16(Bt[n][k], At[m][k], acc[ai][bj][m][n], 0, 0, 0); __builtin_amdgcn_s_setprio(0); } while (0)
#define PG8_WAIT_V(n) asm volatile("s_waitcnt vmcnt(" #n ")" ::: "memory")
#define PG8_WAIT_L(n) asm volatile("s_waitcnt lgkmcnt(" #n ")" ::: "memory")
#define PG8_BAR __builtin_amdgcn_s_barrier()
#define PG8_SCHED __builtin_amdgcn_sched_barrier(0)
    Unit cur, nxt; int ui = 0;
    if (!S.next(0, cur)) return;
    f32x4 acc[2][2][4][2];
#pragma unroll
    for (int a = 0; a < 2; ++a)
#pragma unroll
        for (int b = 0; b < 2; ++b)
#pragma unroll
            for (int m = 0; m < 4; ++m)
#pragma unroll
                for (int n = 0; n < 2; ++n) acc[a][b][m][n] = (f32x4){0.f, 0.f, 0.f, 0.f};
    bf16x8 At[4][2], B0[2][2], B1[2][2];
    const char* cA = (const char*)g.A + (size_t)cur.pm * tstepA; const char* cB = (const char*)g.Bt + (size_t)cur.pn * tstepB;
    PG8_STAGE(PG8_SB(0, 0), cB, voffB); PG8_STAGE(PG8_SA(0, 0), cA, voffA); PG8_STAGE(PG8_SB(0, 1), cB + hstepB, voffB); PG8_STAGE(PG8_SA(0, 1), cA + hstepA, voffA);
    if (wr == 1) PG8_BAR;
    PG8_WAIT_V(4); PG8_BAR;
    PG8_STAGE(PG8_SB(1, 0), cB + kstep, voffB); PG8_STAGE(PG8_SA(1, 0), cA + kstep, voffA); PG8_STAGE(PG8_SB(1, 1), cB + hstepB + kstep, voffB);
    PG8_WAIT_V(6); PG8_BAR;
    for (;;) {
        const bool has_next = S.next(ui + 1, nxt);
        const char* nA = has_next ? (const char*)g.A + (size_t)nxt.pm * tstepA : cA; const char* nB = has_next ? (const char*)g.Bt + (size_t)nxt.pn * tstepB : cB;
        for (int t = 0; t < nt; t += 2) {
            const bool last = (t == nt - 2);
            const char* a1 = cA + (size_t)(t + 1) * kstep;
            const char* a2 = last ? nA : cA + (size_t)(t + 2) * kstep; const char* b2 = last ? nB : cB + (size_t)(t + 2) * kstep;
            const char* a3 = a2 + kstep; const char* b3 = b2 + kstep;
            PG8_LDB(B0, 0, 0); PG8_SCHED; PG8_LDA(At, 0, 0); PG8_STAGE(PG8_SA(1, 1), a1 + hstepA, voffA);
            PG8_WAIT_L(8); PG8_BAR; PG8_WAIT_L(0); PG8_MMA(0, 0, At, B0); PG8_BAR; PG8_SCHED;
            PG8_LDB(B1, 0, 1); PG8_STAGE(PG8_SB(0, 0), b2, voffB);
            PG8_BAR; PG8_WAIT_L(0); PG8_MMA(0, 1, At, B1); PG8_BAR;
            PG8_LDA(At, 0, 1); PG8_STAGE(PG8_SA(0, 0), a2, voffA);
            PG8_BAR; PG8_WAIT_L(0); PG8_MMA(1, 0, At, B0); PG8_BAR; PG8_SCHED;
            PG8_STAGE(PG8_SB(0, 1), b2 + hstepB, voffB);
            PG8_WAIT_V(6); PG8_BAR; PG8_MMA(1, 1, At, B1); PG8_BAR;
            PG8_LDB(B0, 1, 0); PG8_SCHED; PG8_LDA(At, 1, 0); PG8_STAGE(PG8_SA(0, 1), a2 + hstepA, voffA);
            PG8_WAIT_L(8); PG8_BAR; PG8_WAIT_L(0); PG8_MMA(0, 0, At, B0); PG8_BAR; PG8_SCHED;
            PG8_LDB(B1, 1, 1); PG8_STAGE(PG8_SB(1, 0), b3, voffB);
            PG8_BAR; PG8_WAIT_L(0); PG8_MMA(0, 1, At, B1); PG8_BAR;
            PG8_LDA(At, 1, 1); PG8_STAGE(PG8_SA(1, 0), a3, voffA);
            PG8_BAR; PG8_WAIT_L(0); PG8_MMA(1, 0, At, B0); PG8_BAR; PG8_SCHED;
            PG8_STAGE(PG8_SB(1, 1), b3 + hstepB, voffB);
            PG8_WAIT_V(6); PG8_BAR; PG8_MMA(1, 1, At, B1); PG8_BAR;
        }
        E(acc, cur, wr, wc, fr, fq);
        if (!has_next) break;
#pragma unroll
        for (int a = 0; a < 2; ++a)
#pragma unroll
            for (int b = 0; b < 2; ++b)
#pragma unroll
                for (int m = 0; m < 4; ++m)
#pragma unroll
                    for (int n = 0; n < 2; ++n) acc[a][b][m][n] = (f32x4){0.f, 0.f, 0.f, 0.f};
        cur = nxt; cA = nA; cB = nB; ++ui;
    }
    PG8_WAIT_V(0);
    if (wr == 0) PG8_BAR;
    PG8_BAR;
#undef PG8_SA
#undef PG8_SB
#undef PG8_STAGE
#undef PG8_LDA
#undef PG8_LDB
#undef PG8_MMA
#undef PG8_WAIT_V
#undef PG8_WAIT_L
#undef PG8_BAR
#undef PG8_SCHED
}
}

__device__ __forceinline__ const float* xrow_ptr(KA a, int t) { return t < TP ? AIN(I_XP) + (size_t)t * DM : AIN(I_XS) + (size_t)(t - TP) * DM; }
__device__ __forceinline__ void seq_pos(int t, int& pos, int& len) { if (t < TP) { pos = t & 2047; len = 2048; } else { pos = (t - TP) & 4095; len = 4096; } }

__device__ __forceinline__ void transpose_item(const float* W, int K, int N, int Npad, bf16_t* WT, const float* g, LAS float* scr, int item, int lane) {
    const int nblk = Npad / 32, kb = item / nblk, nb = item % nblk, k0 = 64 * kb, n0 = 32 * nb;
#pragma unroll 8
    for (int i = 0; i < 32; ++i) { const int kk = 2 * i + (lane >> 5), n = n0 + (lane & 31); float v = (n < N) ? W[(size_t)(k0 + kk) * N + n] : 0.f; if (g) v *= g[k0 + kk]; scr[kk * 33 + (lane & 31)] = v; }
    LDS_WAIT();
    const int c = lane & 7;
#pragma unroll
    for (int j = 0; j < 4; ++j) { const int n = (lane >> 3) + 8 * j; const LAS float* s = scr + (8 * c) * 33 + n;
        u32x4 o; o.x = pk2(s[0 * 33], s[1 * 33]); o.y = pk2(s[2 * 33], s[3 * 33]); o.z = pk2(s[4 * 33], s[5 * 33]); o.w = pk2(s[6 * 33], s[7 * 33]);
        *(u32x4*)(WT + (size_t)(n0 + n) * K + k0 + 8 * c) = o; }
    LDS_WAIT();
}
__device__ __forceinline__ void row_to_bf16(const float* xrow, bf16_t* orow, float* rs, int lane) {
    const f32x4* xr = (const f32x4*)xrow + lane;
    f32x4 v[4]; float s = 0.f;
#pragma unroll
    for (int j = 0; j < 4; ++j) { v[j] = xr[64 * j]; s += (v[j].x * v[j].x + v[j].y * v[j].y) + (v[j].z * v[j].z + v[j].w * v[j].w); }
    s = wave_sum(s);
    u32x2* o8 = (u32x2*)orow + lane;
#pragma unroll
    for (int j = 0; j < 4; ++j) { u32x2 w; w.x = pk2(v[j].x, v[j].y); w.y = pk2(v[j].z, v[j].w); o8[64 * j] = w; }
    if (lane == 0) *rs = __builtin_amdgcn_rsqf(s * (1.0f / DM) + 1e-6f);
}
__device__ __forceinline__ void p0_phase(KA a, LAS unsigned char* lds, int G, const int tid, const int bid) {
    const int wid = tid >> 6, lane = tid & 63;
    unsigned char* ws = AWS;
    float* sm = (float*)(ws + WS_SMALL);
    LAS float* scr = (LAS float*)(lds + wid * 8704);
    const int gw = bid * 8 + wid, NGW = G * 8;
    constexpr int I0 = 16 * 112, I1 = 16 * 32, I2 = 16 * 32, I3 = 16 * 64, I4 = 16 * 32, I5 = 16 * 128, I6 = 64 * 32;
    constexpr int NIT = I0 + I1 + I2 + I3 + I4 + I5 + I6;
    for (int it = gw; it < NIT; it += NGW) {
        int r = it;
        if (r < I0) { transpose_item(AIN(I_W_IN), 1024, 3504, 3584, (bf16_t*)(ws + WS_WIN), AIN(I_G_MIX_PRE), scr, r, lane); continue; } r -= I0;
        if (r < I1) { transpose_item(AIN(I_W_OUT), 1024, 1024, 1024, (bf16_t*)(ws + WS_WOUT), nullptr, scr, r, lane); continue; } r -= I1;
        if (r < I2) { transpose_item(AIN(I_WQ), 1024, 1024, 1024, (bf16_t*)(ws + WS_WQ), AIN(I_G_X_PRE), scr, r, lane); continue; } r -= I2;
        if (r < I3) { transpose_item(AIN(I_WKV), 1024, 2048, 2048, (bf16_t*)(ws + WS_WKV), AIN(I_G_MEM), scr, r, lane); continue; } r -= I3;
        if (r < I4) { transpose_item(AIN(I_WO), 1024, 1024, 1024, (bf16_t*)(ws + WS_WO), nullptr, scr, r, lane); continue; } r -= I4;
        if (r < I5) { transpose_item(AIN(I_W_FF1), 1024, 4096, 4096, (bf16_t*)(ws + WS_W1), AIN(I_G_FFN_PRE), scr, r, lane); continue; } r -= I5;
        transpose_item(AIN(I_W_FF2), 4096, 1024, 1024, (bf16_t*)(ws + WS_W2), nullptr, scr, r, lane);
    }
    if (bid == 0) for (int i = tid; i < XCD_BAR_WORDS; i += 512) ((unsigned*)ws)[i] = 0u;
    {
        bf16_t* WL = (bf16_t*)(ws + WS_WL);
        for (int idx = bid * 512 + tid; idx < 2560 * 512; idx += G * 512) {
            const int n = idx >> 9, k = idx & 511; const int grp = n >> 9, nn = n & 511;
            float v = 0.f;
            if (grp < 4) { const int kl = k - grp * 64; if (kl >= 0 && kl < 64) { const float* w = grp == 0 ? AIN(I_W2_F) : (grp == 1 ? AIN(I_W2_B) : (grp == 2 ? AIN(I_A2_F) : AIN(I_A2_B))); v = w[kl * 512 + nn]; } }
            else { const int kl = k - 256; if (kl >= 0 && kl < 160) v = AIN(I_G2)[kl * 512 + nn]; }
            WL[idx] = (bf16_t)f2bf(v);
        }
    }
    bf16_t* XB = (bf16_t*)(ws + WS_XB); bf16_t* MB = (bf16_t*)(ws + WS_MEMB);
    for (int t0 = gw; t0 < T_ALL; t0 += 4 * NGW) {
        f32x4 v[4][4]; int tt[4];
#pragma unroll
        for (int q = 0; q < 4; ++q) { tt[q] = t0 + q * NGW < T_ALL ? t0 + q * NGW : t0; const f32x4* xr = (const f32x4*)xrow_ptr(a, tt[q]) + lane;
#pragma unroll
            for (int j = 0; j < 4; ++j) v[q][j] = __builtin_nontemporal_load(xr + 64 * j); }
#pragma unroll
        for (int q = 0; q < 4; ++q) {
            if (q > 0 && tt[q] == t0) continue;
            float s = 0.f;
#pragma unroll
            for (int j = 0; j < 4; ++j) s += (v[q][j].x * v[q][j].x + v[q][j].y * v[q][j].y) + (v[q][j].z * v[q][j].z + v[q][j].w * v[q][j].w);
            s = wave_sum(s);
            u32x2* o8 = (u32x2*)(XB + (size_t)tt[q] * DM) + lane;
#pragma unroll
            for (int j = 0; j < 4; ++j) { u32x2 w; w.x = pk2(v[q][j].x, v[q][j].y); w.y = pk2(v[q][j].z, v[q][j].w); o8[64 * j] = w; }
            if (lane == 0) sm[OFF_RS0 + tt[q]] = __builtin_amdgcn_rsqf(s * (1.0f / DM) + 1e-6f);
        }
    }
    for (int m = gw; m < TM; m += NGW) { const float* mr = m < 2048 ? AIN(I_MP) + (size_t)m * DM : AIN(I_MS) + (size_t)(m - 2048) * DM; row_to_bf16(mr, MB + (size_t)m * DM, sm + OFF_RSM + m, lane); }
    for (int i = bid * 512 + tid; i < 3 * T_ALL; i += G * 512) sm[OFF_SSQ1 + i] = 0.f;
}

__device__ __forceinline__ void ld8nt(const bf16_t* p, float (&o)[8]) { const u32x4 w = __builtin_nontemporal_load((const u32x4*)p); o[0] = bflo(w.x); o[1] = bfhi(w.x); o[2] = bflo(w.y); o[3] = bfhi(w.y); o[4] = bflo(w.z); o[5] = bfhi(w.z); o[6] = bflo(w.w); o[7] = bfhi(w.w); }
__device__ __forceinline__ void ld8(const bf16_t* p, float (&o)[8]) { const u32x4 w = *(const u32x4*)p; o[0] = bflo(w.x); o[1] = bfhi(w.x); o[2] = bflo(w.y); o[3] = bfhi(w.y); o[4] = bflo(w.z); o[5] = bfhi(w.z); o[6] = bflo(w.w); o[7] = bfhi(w.w); }
__device__ __forceinline__ void ldf8(const float* p, float (&o)[8]) { const f32x4 a0 = *(const f32x4*)p, a1 = *(const f32x4*)(p + 4); o[0] = a0.x; o[1] = a0.y; o[2] = a0.z; o[3] = a0.w; o[4] = a1.x; o[5] = a1.y; o[6] = a1.z; o[7] = a1.w; }
__device__ __forceinline__ u32x4 st8(const float (&v)[8]) { u32x4 w; w.x = pk2(v[0], v[1]); w.y = pk2(v[2], v[3]); w.z = pk2(v[4], v[5]); w.w = pk2(v[6], v[7]); return w; }
__device__ __forceinline__ void shift8(const bf16_t* P, int col, bool first, bool last, const float (&mp)[8], const float (&mn)[8], float (&o)[8]) {
    float c[8], pv[8], nx[8];
    ld8(P + col, c); ld8(P + col - (first ? 0 : PROJ_LD), pv); ld8(P + col + (last ? 0 : PROJ_LD), nx);
#pragma unroll
    for (int j = 0; j < 8; ++j) { const float pp = first ? 0.f : pv[j], pn = last ? 0.f : nx[j]; o[j] = c[j] + mp[j] * (pp - c[j]) + mn[j] * (pn - c[j]); }
}
__device__ __forceinline__ void p2_phase(KA a, int G, const int tid, const int bid) {
    const int wid = tid >> 6, lane = tid & 63;
    unsigned char* ws = AWS;
    const bf16_t* PROJ = (const bf16_t*)(ws + WS_PROJ); bf16_t* AL = (bf16_t*)(ws + WS_AL); float* KSC = (float*)(ws + WS_SMALL) + OFF_KSC;
    const int gw = bid * 8 + wid, NGW = G * 8;
    const int lcol = 1536 + 8 * (lane < 52 ? lane : 0), kcol = 512 + 8 * lane;
    float mpl[8], mnl[8], mpk[8], mnk[8], kkv[8];
    ldf8(AIN(I_MU_PREV) + lcol, mpl); ldf8(AIN(I_MU_NEXT) + lcol, mnl); ldf8(AIN(I_MU_PREV) + kcol, mpk); ldf8(AIN(I_MU_NEXT) + kcol, mnk); ldf8(AIN(I_K_K) + 8 * lane, kkv);
    for (int t = gw; t < T_ALL; t += NGW) {
        int pos, len; seq_pos(t, pos, len); const bool first = pos == 0, last = pos == len - 1;
        const bf16_t* P = PROJ + (size_t)t * PROJ_LD;
        float sh[8], kk[8];
        shift8(P, lcol, first, last, mpl, mnl, sh);
        shift8(P, kcol, first, last, mpk, mnk, kk);
        if (lane < 16) {
#pragma unroll
            for (int j = 0; j < 8; ++j) sh[j] = 1.0f - 2.0f * __builtin_amdgcn_rcpf(__expf(2.0f * sh[j]) + 1.0f);
        } else if (lane >= 32) {
#pragma unroll
            for (int j = 0; j < 8; ++j) sh[j] = sigmoidf_(sh[j]);
        }
        if (lane >= 52) {
#pragma unroll
            for (int j = 0; j < 8; ++j) sh[j] = 0.f;
        }
        *(u32x4*)(AL + (size_t)t * 512 + 8 * lane) = st8(sh);
        float s = 0.f;
#pragma unroll
        for (int j = 0; j < 8; ++j) { const float x = kk[j] * kkv[j]; s += x * x; }
        s += __shfl_xor(s, 1); s += __shfl_xor(s, 2); s += __shfl_xor(s, 4);
        if ((lane & 7) == 0) KSC[(size_t)t * 8 + (lane >> 3)] = __builtin_amdgcn_rsqf(s + 1e-12f);
    }
}

constexpr int SC_TB = 8;
__device__ __forceinline__ void scan_phase(KA a, LAS unsigned char* lds, int G, const int tid, const int bid) {
    const int wid = __builtin_amdgcn_readfirstlane(tid >> 6), lane = tid & 63;
    unsigned char* ws = AWS;
    const bf16_t* PROJ = (const bf16_t*)(ws + WS_PROJ); const bf16_t* LO = (const bf16_t*)AOUT; const float* KSC = (const float*)(ws + WS_SMALL) + OFF_KSC;
    LAS float* L = (LAS float*)(lds + wid * (SC_TB * 6 * 256));
    for (int u = wid * G + bid; u < 384; u += 8 * G) {
        int row0, len, h, dir;
        if (u < 256) { row0 = TP + (u >> 4) * 4096; len = 4096; h = (u >> 1) & 7; dir = u & 1; }
        else { const int v = u - 256; row0 = (v >> 4) * 2048; len = 2048; h = (v >> 1) & 7; dir = v & 1; }
        const int c = h * 64 + lane;
        const float mpr = AIN(I_MU_PREV)[c], mnr = AIN(I_MU_NEXT)[c], mpk = AIN(I_MU_PREV)[512 + c], mnk = AIN(I_MU_NEXT)[512 + c], mpv = AIN(I_MU_PREV)[1024 + c], mnv = AIN(I_MU_NEXT)[1024 + c];
        const float kkc = AIN(I_K_K)[c], kac = AIN(I_K_A)[c];
        bf16_t* Y = (bf16_t*)(ws + (dir ? WS_YB : WS_YF));
        const int d = dir ? -1 : 1, t0 = dir ? len - 1 : 0;
        float S[64];
#pragma unroll
        for (int j = 0; j < 64; ++j) S[j] = 0.f;
        float rB = 0.f, kB = 0.f, vB = 0.f, rC, kC, vC;
        { const bf16_t* P = PROJ + (size_t)(row0 + t0) * PROJ_LD; rC = bf2f(P[c]); kC = bf2f(P[512 + c]); vC = bf2f(P[1024 + c]); }
        unsigned rawR[SC_TB], rawK[SC_TB], rawV[SC_TB], rawL[SC_TB], rawA[SC_TB]; float rawS[SC_TB];
        const int nb = len / SC_TB;
#define SC_LOAD(b_) do { _Pragma("unroll") for (int s = 0; s < SC_TB; ++s) { const int t = t0 + d * ((b_) * SC_TB + s); int ta = t + d; ta = ta < 0 ? 0 : (ta >= len ? len - 1 : ta); \
            const bf16_t* P = PROJ + (size_t)(row0 + ta) * PROJ_LD; rawR[s] = P[c]; rawK[s] = P[512 + c]; rawV[s] = P[1024 + c]; \
            const bf16_t* Q = LO + (size_t)(row0 + t) * 2048; rawL[s] = Q[dir * 512 + c]; rawA[s] = Q[1024 + dir * 512 + c]; rawS[s] = KSC[(size_t)(row0 + t) * 8 + h]; } } while (0)
        SC_LOAD(0);
        for (int b = 0; b < nb; ++b) {
#pragma unroll
            for (int s = 0; s < SC_TB; ++s) {
                const int t = t0 + d * (b * SC_TB + s); const int ta = t + d; const bool va = ta >= 0 && ta < len;
                const float rA = va ? bf2f(rawR[s]) : 0.f, kA = va ? bf2f(rawK[s]) : 0.f, vA = va ? bf2f(rawV[s]) : 0.f;
                const float rp = dir ? rA : rB, rn = dir ? rB : rA, kp = dir ? kA : kB, kn = dir ? kB : kA, vp = dir ? vA : vB, vn = dir ? vB : vA;
                const float r = rC + mpr * (rp - rC) + mnr * (rn - rC);
                const float k = kC + mpk * (kp - kC) + mnk * (kn - kC);
                const float v = vC + mpv * (vp - vC) + mnv * (vn - vC);
                const float av = bf2f(rawA[s]), w = __expf(bf2f(rawL[s]));
                const float kk = k * kkc * rawS[s];
                LAS float* Ls = L + s * 384;
                Ls[lane] = w; Ls[64 + lane] = kk * av; Ls[128 + lane] = -kk; Ls[192 + lane] = k * (1.0f + (av - 1.0f) * kac); Ls[256 + lane] = r; Ls[320 + lane] = v;
                rB = rC; kB = kC; vB = vC; rC = rA; kC = kA; vC = vA;
            }
            if (b + 1 < nb) SC_LOAD(b + 1);
            LDS_WAIT();
#pragma unroll 2
            for (int s = 0; s < SC_TB; ++s) {
                const LAS float* Ls = L + s * 384;
                const LAS f32x4* W4 = (const LAS f32x4*)Ls; const LAS f32x4* B4 = (const LAS f32x4*)(Ls + 64); const LAS f32x4* N4 = (const LAS f32x4*)(Ls + 128);
                const LAS f32x4* K4 = (const LAS f32x4*)(Ls + 192); const LAS f32x4* R4 = (const LAS f32x4*)(Ls + 256);
                const float v = Ls[320 + lane];
                float s0 = 0.f, s1 = 0.f, s2 = 0.f, s3 = 0.f;
#pragma unroll
                for (int q = 0; q < 16; ++q) { const f32x4 n4 = N4[q]; s0 += S[4 * q] * n4.x; s1 += S[4 * q + 1] * n4.y; s2 += S[4 * q + 2] * n4.z; s3 += S[4 * q + 3] * n4.w; }
                const float sa = (s0 + s1) + (s2 + s3);
                float y0 = 0.f, y1 = 0.f, y2 = 0.f, y3 = 0.f;
#pragma unroll
                for (int q = 0; q < 16; ++q) {
                    const f32x4 w4 = W4[q], b4 = B4[q], k4 = K4[q], r4 = R4[q];
                    S[4 * q]     = S[4 * q]     * w4.x + (sa * b4.x + v * k4.x); y0 += S[4 * q]     * r4.x;
                    S[4 * q + 1] = S[4 * q + 1] * w4.y + (sa * b4.y + v * k4.y); y1 += S[4 * q + 1] * r4.y;
                    S[4 * q + 2] = S[4 * q + 2] * w4.z + (sa * b4.z + v * k4.z); y2 += S[4 * q + 2] * r4.z;
                    S[4 * q + 3] = S[4 * q + 3] * w4.w + (sa * b4.w + v * k4.w); y3 += S[4 * q + 3] * r4.w;
                }
                const int t = t0 + d * (b * SC_TB + s);
                Y[(size_t)(row0 + t) * 512 + c] = (bf16_t)f2bf((y0 + y1) + (y2 + y3));
            }
            LDS_WAIT();
        }
#undef SC_LOAD
    }
}


__device__ __forceinline__ void scan2_phase(KA a, LAS unsigned char* lds, int G, const int tid, const int bid) {
    const int wid = __builtin_amdgcn_readfirstlane(tid >> 6), lane = tid & 63, fr = lane & 15, fq = lane >> 4;
    const int grp = wid >> 2, r = wid & 3;
    const int mid = (r - grp) & 3;
    unsigned char* ws = AWS;
    const bf16_t* PROJ = (const bf16_t*)(ws + WS_PROJ); const bf16_t* LO = (const bf16_t*)AOUT; const float* KSC = (const float*)(ws + WS_SMALL) + OFF_KSC;
    LAS unsigned char* gl0 = lds + grp * 57344;
    const int npair = bid < 128 ? 1 : 2, pbase = bid < 128 ? bid : 128 + 2 * (bid - 128);
    for (int pi = 0; pi < npair; ++pi) {
        const int p = pbase + pi;
        const int u = 2 * p + grp;
        int row0, len, h, dir;
        if (u < 256) { row0 = TP + (u >> 4) * 4096; len = 4096; h = (u >> 1) & 7; dir = u & 1; }
        else { const int v = u - 256; row0 = (v >> 4) * 2048; len = 2048; h = (v >> 1) & 7; dir = v & 1; }
        const int c = h * 64 + lane;
        const float mpr = AIN(I_MU_PREV)[c], mnr = AIN(I_MU_NEXT)[c], mpk = AIN(I_MU_PREV)[512 + c], mnk = AIN(I_MU_NEXT)[512 + c], mpv = AIN(I_MU_PREV)[1024 + c], mnv = AIN(I_MU_NEXT)[1024 + c];
        const float kkc = AIN(I_K_K)[c], kac = AIN(I_K_A)[c];
        bf16_t* Y = (bf16_t*)(ws + (dir ? WS_YB : WS_YF));
        f32x4 accS[4];
#pragma unroll
        for (int j = 0; j < 4; ++j) accS[j] = (f32x4){0.f, 0.f, 0.f, 0.f};
        unsigned rawR[6], rawK[6], rawV[6], rawL[4], rawA[4]; float rawS[4];
        const int nb = len / 16;
#define SC2_LOAD(b_) do { const int tau0 = (b_) * 16 + 4 * r; const int tmin = dir ? len - 4 - tau0 : tau0; \
            _Pragma("unroll") for (int m = 0; m < 6; ++m) { int ar = tmin - 1 + m; ar = ar < 0 ? 0 : (ar >= len ? len - 1 : ar); const bf16_t* P = PROJ + (size_t)(row0 + ar) * PROJ_LD; rawR[m] = P[c]; rawK[m] = P[512 + c]; rawV[m] = P[1024 + c]; } \
            _Pragma("unroll") for (int i = 0; i < 4; ++i) { const int t = dir ? len - 1 - tau0 - i : tau0 + i; const bf16_t* Q = LO + (size_t)(row0 + t) * 2048; rawL[i] = Q[dir * 512 + c]; rawA[i] = Q[1024 + dir * 512 + c]; rawS[i] = KSC[(size_t)(row0 + t) * 8 + h]; } } while (0)
        SC2_LOAD(0);
        for (int b = 0; b < nb; ++b) {
            LAS unsigned char* gl = gl0 + (b & 1) * 28672;
            LAS bf16_t* At = (LAS bf16_t*)gl; LAS bf16_t* Rt = At + 16 * 72; LAS bf16_t* Bs = Rt + 16 * 72; LAS bf16_t* Ks = Bs + 16 * 72;
            LAS bf16_t* BT = Ks + 16 * 72; LAS bf16_t* KT = BT + 64 * 24; LAS bf16_t* VT = KT + 64 * 24;
            LAS bf16_t* MkaT = VT + 64 * 24; LAS bf16_t* MbrT = MkaT + 16 * 24; LAS bf16_t* MkrT = MbrT + 16 * 24;
            LAS float* Nf = (LAS float*)(MkrT + 16 * 24); LAS float* TTf = Nf + 16 * 20; LAS float* Pc = TTf + 16 * 20; LAS float* tot = Pc + 64;
            const int tau0 = b * 16 + 4 * r; const int tmin = dir ? len - 4 - tau0 : tau0;
            float xr[6], xk[6], xv[6];
#pragma unroll
            for (int m = 0; m < 6; ++m) { const int ar = tmin - 1 + m; const bool ok = ar >= 0 && ar < len; xr[m] = ok ? bf2f(rawR[m]) : 0.f; xk[m] = ok ? bf2f(rawK[m]) : 0.f; xv[m] = ok ? bf2f(rawV[m]) : 0.f; }
            float Lv[4], cl[4];
#pragma unroll
            for (int i = 0; i < 4; ++i) { Lv[i] = bf2f(rawL[i]); cl[i] = i ? cl[i - 1] + Lv[i] : Lv[i]; }
            tot[r * 64 + lane] = cl[3];
            BAR_LDS();
            float off = 0.f, all = 0.f;
#pragma unroll
            for (int w2 = 0; w2 < 4; ++w2) { const float x = tot[w2 * 64 + lane]; all += x; if (w2 < r) off += x; }
            float bt[4], kt[4], vt[4];
#pragma unroll
            for (int i = 0; i < 4; ++i) {
                const float rc = dir ? xr[4 - i] : xr[1 + i], rp = dir ? xr[3 - i] : xr[i], rn = dir ? xr[5 - i] : xr[2 + i];
                const float kc = dir ? xk[4 - i] : xk[1 + i], kp = dir ? xk[3 - i] : xk[i], kn = dir ? xk[5 - i] : xk[2 + i];
                const float vc = dir ? xv[4 - i] : xv[1 + i], vp = dir ? xv[3 - i] : xv[i], vn = dir ? xv[5 - i] : xv[2 + i];
                const float rr = rc + mpr * (rp - rc) + mnr * (rn - rc);
                const float k = kc + mpk * (kp - kc) + mnk * (kn - kc);
                const float v = vc + mpv * (vp - vc) + mnv * (vn - vc);
                const float av = bf2f(rawA[i]);
                const float cum = cl[i] + off;
                const float Pin = __expf(cum), Pprev = __expf(cum - Lv[i]), Pinv = __expf(-cum);
                const float kk = k * kkc * rawS[i];
                const float bb = kk * av * Pinv, kd = k * (1.0f + (av - 1.0f) * kac) * Pinv;
                const int tau = 4 * r + i;
                At[tau * 72 + lane] = (bf16_t)f2bf(-kk * Pprev); Rt[tau * 72 + lane] = (bf16_t)f2bf(rr * Pin); Bs[tau * 72 + lane] = (bf16_t)f2bf(bb); Ks[tau * 72 + lane] = (bf16_t)f2bf(kd);
                bt[i] = bb; kt[i] = kd; vt[i] = v;
            }
            { u32x2 w; w.x = pk2(bt[0], bt[1]); w.y = pk2(bt[2], bt[3]); *(LAS u32x2*)(BT + lane * 24 + 4 * r) = w; }
            { u32x2 w; w.x = pk2(kt[0], kt[1]); w.y = pk2(kt[2], kt[3]); *(LAS u32x2*)(KT + lane * 24 + 4 * r) = w; }
            { u32x2 w; w.x = pk2(vt[0], vt[1]); w.y = pk2(vt[2], vt[3]); *(LAS u32x2*)(VT + lane * 24 + 4 * r) = w; }
            if (r == 0) Pc[lane] = __expf(all);
            if (b + 1 < nb) SC2_LOAD(b + 1);
            BAR_LDS();
            {
                const LAS bf16_t* As = (mid & 1) ? Ks : Bs; const LAS bf16_t* Bsrc = (mid < 2) ? At : Rt;
                f32x4 m = (f32x4){0.f, 0.f, 0.f, 0.f};
#pragma unroll
                for (int ks = 0; ks < 2; ++ks) { const bf16x8 af = *(const LAS bf16x8*)(As + fr * 72 + 32 * ks + 8 * fq), bfv = *(const LAS bf16x8*)(Bsrc + fr * 72 + 32 * ks + 8 * fq); m = __builtin_amdgcn_mfma_f32_16x16x32_bf16(af, bfv, m, 0, 0, 0); }
#pragma unroll
                for (int i = 0; i < 4; ++i) { const int s = 4 * fq + i; const bool keep = (s < fr) || (mid >= 2 && s == fr); m[i] = keep ? m[i] : 0.f; }
                if (mid == 0) {
#pragma unroll
                    for (int i = 0; i < 4; ++i) Nf[(4 * fq + i) * 20 + fr] = m[i];
                }
                else { u32x2 w; w.x = pk2(m[0], m[1]); w.y = pk2(m[2], m[3]); LAS bf16_t* dst = mid == 1 ? MkaT : (mid == 2 ? MbrT : MkrT); *(LAS u32x2*)(dst + fr * 24 + 4 * fq) = w; }
            }
            if (mid == 0) {
                float acc[16];
#pragma unroll
                for (int tp = 0; tp < 16; ++tp) acc[tp] = (fr == tp) ? 1.0f : 0.f;
#pragma unroll
                for (int s2 = 0; s2 < 15; ++s2) {
                    const float ts = acc[s2];
#pragma unroll
                    for (int q = 0; q < 4; ++q) {
                        if (4 * q + 3 > s2) {
                            const f32x4 n4 = *(const LAS f32x4*)(Nf + s2 * 20 + 4 * q);
                            if (4 * q + 0 > s2) acc[4 * q + 0] += ts * n4.x;
                            if (4 * q + 1 > s2) acc[4 * q + 1] += ts * n4.y;
                            if (4 * q + 2 > s2) acc[4 * q + 2] += ts * n4.z;
                            if (4 * q + 3 > s2) acc[4 * q + 3] += ts * n4.w;
                        }
                    }
                }
                if (fq == 0) {
#pragma unroll
                    for (int tp = 0; tp < 16; ++tp) TTf[tp * 20 + fr] = acc[tp];
                }
            }
            BAR_LDS();
            const u32x2 z2 = (u32x2){0u, 0u};
            bf16x8 sb[2];
#pragma unroll
            for (int kb = 0; kb < 2; ++kb) { u32x4 w; w.x = pk2(accS[2 * kb][0], accS[2 * kb][1]); w.y = pk2(accS[2 * kb][2], accS[2 * kb][3]); w.z = pk2(accS[2 * kb + 1][0], accS[2 * kb + 1][1]); w.w = pk2(accS[2 * kb + 1][2], accS[2 * kb + 1][3]); sb[kb] = __builtin_bit_cast(bf16x8, w); }
            const u32x2 vlo = *(const LAS u32x2*)(VT + (16 * r + fr) * 24 + 4 * fq);
            f32x4 accX = (f32x4){0.f, 0.f, 0.f, 0.f}, accY = (f32x4){0.f, 0.f, 0.f, 0.f};
#pragma unroll
            for (int kb = 0; kb < 2; ++kb) { const u32x2 lo = *(const LAS u32x2*)(At + fr * 72 + 32 * kb + 4 * fq), hi = *(const LAS u32x2*)(At + fr * 72 + 32 * kb + 16 + 4 * fq); accX = __builtin_amdgcn_mfma_f32_16x16x32_bf16(mk8(lo, hi), sb[kb], accX, 0, 0, 0); }
            { const u32x2 alo = *(const LAS u32x2*)(MkaT + fr * 24 + 4 * fq); accX = __builtin_amdgcn_mfma_f32_16x16x32_bf16(mk8(alo, z2), mk8(vlo, z2), accX, 0, 0, 0); }
#pragma unroll
            for (int kb = 0; kb < 2; ++kb) { const u32x2 lo = *(const LAS u32x2*)(Rt + fr * 72 + 32 * kb + 4 * fq), hi = *(const LAS u32x2*)(Rt + fr * 72 + 32 * kb + 16 + 4 * fq); accY = __builtin_amdgcn_mfma_f32_16x16x32_bf16(mk8(lo, hi), sb[kb], accY, 0, 0, 0); }
            {
                f32x4 accSA = (f32x4){0.f, 0.f, 0.f, 0.f};
#pragma unroll
                for (int kk = 0; kk < 4; ++kk) accSA = __builtin_amdgcn_mfma_f32_16x16x4f32(TTf[fr * 20 + 4 * fq + kk], accX[kk], accSA, 0, 0, 0);
                u32x2 sav; sav.x = pk2(accSA[0], accSA[1]); sav.y = pk2(accSA[2], accSA[3]);
                const bf16x8 bsv = mk8(sav, vlo);
                { const u32x2 lo = *(const LAS u32x2*)(MbrT + fr * 24 + 4 * fq), hi = *(const LAS u32x2*)(MkrT + fr * 24 + 4 * fq); accY = __builtin_amdgcn_mfma_f32_16x16x32_bf16(mk8(lo, hi), bsv, accY, 0, 0, 0); }
#pragma unroll
                for (int i = 0; i < 4; ++i) { const int tau = b * 16 + 4 * fq + i; const int t = dir ? len - 1 - tau : tau; Y[(size_t)(row0 + t) * 512 + h * 64 + 16 * r + fr] = (bf16_t)f2bf(accY[i]); }
#pragma unroll
                for (int jt = 0; jt < 4; ++jt) {
                    const u32x2 lo = *(const LAS u32x2*)(BT + (16 * jt + fr) * 24 + 4 * fq), hi = *(const LAS u32x2*)(KT + (16 * jt + fr) * 24 + 4 * fq);
                    accS[jt] = __builtin_amdgcn_mfma_f32_16x16x32_bf16(mk8(lo, hi), bsv, accS[jt], 0, 0, 0);
                    const f32x4 pc4 = *(const LAS f32x4*)(Pc + 16 * jt + 4 * fq);
                    accS[jt] = accS[jt] * pc4;
                }
            }
        }
        BAR_LDS();
#undef SC2_LOAD
    }
}

__device__ __forceinline__ void gla_phase(KA a, LAS unsigned char* lds, int G, const int tid, const int bid) {
    const int wid = __builtin_amdgcn_readfirstlane(tid >> 6), lane = tid & 63, fr = lane & 15, fq = lane >> 4;
    unsigned char* ws = AWS;
    const bf16_t* PROJ = (const bf16_t*)(ws + WS_PROJ); bf16_t* MIX = (bf16_t*)(ws + WS_MIXED);
    constexpr int SD = 72;
    LAS bf16_t* Qin = (LAS bf16_t*)lds; LAS bf16_t* Kin = Qin + 64 * SD; LAS bf16_t* KdT = Kin + 64 * SD; LAS bf16_t* VT = KdT + 64 * SD; LAS bf16_t* STt = VT + 128 * SD;
    LAS float* tot = (LAS float*)(STt + 128 * SD); LAS float* bl = tot + 8 * 64;
    const int tt = wid & 3, eh = wid >> 2, dt = wid & 3, etg = (wid >> 2) * 4;
    const int gj = bid - 160;
    for (int ui = 0; ui < 2; ++ui) {
        const int u = 2 * gj + ui;
        int row0, len, h, dir;
        if (u < 128) { row0 = TP + (u >> 3) * 4096; len = 4096; h = (u >> 1) & 3; dir = u & 1; } else { const int v = u - 128; row0 = (v >> 3) * 2048; len = 2048; h = (v >> 1) & 3; dir = v & 1; }
        const int nch = len / 64;
        const int dtile = wid & 3, th = wid >> 2, d0 = 16 * dtile;
        u32x2 gb2;
        { const float* g2 = AIN(dir ? I_GK2_B : I_GK2_F) + h * 64 + d0 + fr; gb2.x = pk2(g2[(4 * fq) * 256], g2[(4 * fq + 1) * 256]); gb2.y = pk2(g2[(4 * fq + 2) * 256], g2[(4 * fq + 3) * 256]); }
        const float gkb = AIN(dir ? I_GKB_B : I_GKB_F)[h * 64 + d0 + fr];
        f32x4 accS[4];
#pragma unroll
        for (int e4 = 0; e4 < 4; ++e4) accS[e4] = (f32x4){0.f, 0.f, 0.f, 0.f};
        BAR_LDS();
        for (int i = tid; i < 128 * SD / 2; i += 512) ((LAS unsigned*)STt)[i] = 0u;
        unsigned qraw[8], kraw[8], vraw[16]; u32x2 graw[2];
        const unsigned qoff = (unsigned)((32 * th + 4 * fq) * PROJ_LD + h * 64 + d0 + fr);
        const unsigned voff = (unsigned)((8 * wid) * PROJ_LD + 512 + h * 128 + lane);
        const unsigned goff = (unsigned)((32 * th + fr) * PROJ_LD + 1024 + 4 * fq);
#define GLA_LOAD(n_) do { const bf16_t* Pc = PROJ + (size_t)(row0 + (n_) * 64) * PROJ_LD + 1952; \
        _Pragma("unroll") for (int tti = 0; tti < 2; ++tti) { _Pragma("unroll") for (int i = 0; i < 4; ++i) { const unsigned o = qoff + (unsigned)((16 * tti + i) * PROJ_LD); qraw[4 * tti + i] = Pc[o]; kraw[4 * tti + i] = Pc[o + 256]; } \
            graw[tti] = *(const u32x2*)(Pc + goff + (unsigned)(16 * tti * PROJ_LD)); } \
        _Pragma("unroll") for (int i = 0; i < 8; ++i) { const unsigned o = voff + (unsigned)(i * PROJ_LD); vraw[i] = Pc[o]; vraw[8 + i] = Pc[o + 64]; } } while (0)
        GLA_LOAD(dir ? nch - 1 : 0);
        for (int ci = 0; ci < nch; ++ci) {
            const int n = dir ? nch - 1 - ci : ci; const int crow = row0 + n * 64;
            const u32x2 z2 = (u32x2){0u, 0u};
            float lg[2][4], pre[2][4];
            float run = 0.f;
#pragma unroll
            for (int tti = 0; tti < 2; ++tti) {
                const f32x4 z4 = __builtin_amdgcn_mfma_f32_16x16x32_bf16(mk8(graw[tti], z2), mk8(gb2, z2), (f32x4){0.f, 0.f, 0.f, 0.f}, 0, 0, 0);
#pragma unroll
                for (int i = 0; i < 4; ++i) { const float z = z4[i] + gkb; const float az = fabsf(z); lg[tti][i] = ((z < 0.f ? z : 0.f) - __logf(1.0f + __expf(-az))) * (1.0f / 16.0f); }
                float c0 = lg[tti][0], c1 = c0 + lg[tti][1], c2 = c1 + lg[tti][2], c3 = c2 + lg[tti][3];
                float x = c3;
                { const float y = __shfl_up(x, 16); if (fq >= 1) x += y; }
                { const float y = __shfl_up(x, 32); if (fq >= 2) x += y; }
                const float excl = x - c3 + run;
                pre[tti][0] = c0 + excl; pre[tti][1] = c1 + excl; pre[tti][2] = c2 + excl; pre[tti][3] = c3 + excl;
                run += __shfl(x, 48 + fr);
            }
            if (fq == 0) tot[th * 64 + d0 + fr] = run;
            BAR_LDS();
            const float t0s = tot[d0 + fr], t1s = tot[64 + d0 + fr];
            const float all = t0s + t1s, offp = th ? t0s : 0.f;
            const float eall = __expf(all);
#pragma unroll
            for (int tti = 0; tti < 2; ++tti) {
                float kd[4];
#pragma unroll
                for (int i = 0; i < 4; ++i) {
                    const float pin = pre[tti][i] + offp;
                    const float bb = dir ? (all - pin + lg[tti][i]) : pin;
                    const float q = bf2f(qraw[4 * tti + i]) * 0.125f, k = bf2f(kraw[4 * tti + i]);
                    const float eb = __expf(bb), ieb = __builtin_amdgcn_rcpf(eb);
                    const int t = 32 * th + 16 * tti + 4 * fq + i;
                    Qin[t * SD + d0 + fr] = (bf16_t)f2bf(q * eb);
                    const float kin = k * ieb;
                    Kin[t * SD + d0 + fr] = (bf16_t)f2bf(kin);
                    kd[i] = kin * eall;
                }
                u32x2 w; w.x = pk2(kd[0], kd[1]); w.y = pk2(kd[2], kd[3]); *(LAS u32x2*)(KdT + (d0 + fr) * SD + 32 * th + 16 * tti + 4 * fq) = w;
            }
            { u32x4 w; w.x = vraw[0] | (vraw[1] << 16); w.y = vraw[2] | (vraw[3] << 16); w.z = vraw[4] | (vraw[5] << 16); w.w = vraw[6] | (vraw[7] << 16); *(LAS u32x4*)(VT + lane * SD + 8 * wid) = w; }
            { u32x4 w; w.x = vraw[8] | (vraw[9] << 16); w.y = vraw[10] | (vraw[11] << 16); w.z = vraw[12] | (vraw[13] << 16); w.w = vraw[14] | (vraw[15] << 16); *(LAS u32x4*)(VT + (64 + lane) * SD + 8 * wid) = w; }
            if (th == 0 && fq == 0) bl[d0 + fr] = eall;
            { const int cn = ci + 1 < nch ? ci + 1 : ci; GLA_LOAD(dir ? nch - 1 - cn : cn); }
            BAR_LDS();
            bf16x8 qf[2];
#pragma unroll
            for (int ks = 0; ks < 2; ++ks) qf[ks] = *(const LAS bf16x8*)(Qin + (16 * tt + fr) * SD + 32 * ks + 8 * fq);
            f32x4 accA[4];
#pragma unroll
            for (int st = 0; st < 4; ++st) { accA[st] = (f32x4){0.f, 0.f, 0.f, 0.f};
#pragma unroll
                for (int ks = 0; ks < 2; ++ks) { const bf16x8 kf = *(const LAS bf16x8*)(Kin + (16 * st + fr) * SD + 32 * ks + 8 * fq); accA[st] = __builtin_amdgcn_mfma_f32_16x16x32_bf16(kf, qf[ks], accA[st], 0, 0, 0); } }
            const int tq = 16 * tt + fr;
#pragma unroll
            for (int st = 0; st < 4; ++st)
#pragma unroll
                for (int i = 0; i < 4; ++i) { const int s = 16 * st + 4 * fq + i; const bool keep = dir ? (s >= tq) : (s <= tq); accA[st][i] = keep ? accA[st][i] : 0.f; }
            bf16x8 pf[2];
#pragma unroll
            for (int kb = 0; kb < 2; ++kb) { u32x4 w; w.x = pk2(accA[2 * kb][0], accA[2 * kb][1]); w.y = pk2(accA[2 * kb][2], accA[2 * kb][3]); w.z = pk2(accA[2 * kb + 1][0], accA[2 * kb + 1][1]); w.w = pk2(accA[2 * kb + 1][2], accA[2 * kb + 1][3]); pf[kb] = __builtin_bit_cast(bf16x8, w); }
            f32x4 accO[4];
#pragma unroll
            for (int et = 0; et < 4; ++et) {
                accO[et] = (f32x4){0.f, 0.f, 0.f, 0.f};
                const int E = eh * 64 + 16 * et;
#pragma unroll
                for (int kb = 0; kb < 2; ++kb) {
                    const u32x2 lo = *(const LAS u32x2*)(VT + (E + fr) * SD + 32 * kb + 4 * fq), hi = *(const LAS u32x2*)(VT + (E + fr) * SD + 32 * kb + 16 + 4 * fq);
                    accO[et] = __builtin_amdgcn_mfma_f32_16x16x32_bf16(mk8(lo, hi), pf[kb], accO[et], 0, 0, 0);
                }
#pragma unroll
                for (int ks = 0; ks < 2; ++ks) { const bf16x8 sf = *(const LAS bf16x8*)(STt + (E + fr) * SD + 32 * ks + 8 * fq); accO[et] = __builtin_amdgcn_mfma_f32_16x16x32_bf16(sf, qf[ks], accO[et], 0, 0, 0); }
            }
            const f32x4 dec = *(const LAS f32x4*)(bl + 16 * dt + 4 * fq);
#pragma unroll
            for (int e4 = 0; e4 < 4; ++e4) {
                accS[e4] = accS[e4] * dec;
                const int Et = (etg + e4) * 16;
#pragma unroll
                for (int kb = 0; kb < 2; ++kb) {
                    const bf16x8 kdf = *(const LAS bf16x8*)(KdT + (16 * dt + fr) * SD + 32 * kb + 8 * fq);
                    const bf16x8 vf = *(const LAS bf16x8*)(VT + (Et + fr) * SD + 32 * kb + 8 * fq);
                    accS[e4] = __builtin_amdgcn_mfma_f32_16x16x32_bf16(kdf, vf, accS[e4], 0, 0, 0);
                }
            }
            bf16_t* orow = MIX + (size_t)(crow + tq) * 1024 + 512 + h * 128 + eh * 64 + 4 * fq;
            if (dir == 1) {
#pragma unroll
                for (int et = 0; et < 4; ++et) { const u32x2 w = *(const u32x2*)(orow + 16 * et); accO[et][0] += bflo(w.x); accO[et][1] += bfhi(w.x); accO[et][2] += bflo(w.y); accO[et][3] += bfhi(w.y); }
            }
#pragma unroll
            for (int et = 0; et < 4; ++et) { u32x2 w; w.x = pk2(accO[et][0], accO[et][1]); w.y = pk2(accO[et][2], accO[et][3]); *(u32x2*)(orow + 16 * et) = w; }
            BAR_LDS();
#pragma unroll
            for (int e4 = 0; e4 < 4; ++e4) { u32x2 w; w.x = pk2(accS[e4][0], accS[e4][1]); w.y = pk2(accS[e4][2], accS[e4][3]); *(LAS u32x2*)(STt + ((etg + e4) * 16 + fr) * SD + 16 * dt + 4 * fq) = w; }
        }
#undef GLA_LOAD
    }
}

__device__ __forceinline__ void combine_phase(KA a, int G, const int tid, const int bid) {
    const int wid = tid >> 6, lane = tid & 63;
    unsigned char* ws = AWS;
    const bf16_t* PROJ = (const bf16_t*)(ws + WS_PROJ); const bf16_t* LO = (const bf16_t*)AOUT; const bf16_t* YF = (const bf16_t*)(ws + WS_YF); const bf16_t* YB = (const bf16_t*)(ws + WS_YB);
    const bf16_t* GB = (const bf16_t*)(ws + WS_GB); bf16_t* MIX = (bf16_t*)(ws + WS_MIXED);
    const int gw = bid * 8 + wid, NGW = G * 8;
    const int c0 = 8 * lane;
    float mpr[8], mnr[8], mpk[8], mnk[8], mpv[8], mnv[8], kav[8], rkv[8], lw[8], lb[8];
    ldf8(AIN(I_MU_PREV) + c0, mpr); ldf8(AIN(I_MU_NEXT) + c0, mnr); ldf8(AIN(I_MU_PREV) + 512 + c0, mpk); ldf8(AIN(I_MU_NEXT) + 512 + c0, mnk);
    ldf8(AIN(I_MU_PREV) + 1024 + c0, mpv); ldf8(AIN(I_MU_NEXT) + 1024 + c0, mnv); ldf8(AIN(I_K_A) + c0, kav); ldf8(AIN(I_R_K) + c0, rkv); ldf8(AIN(I_LNX_W) + c0, lw); ldf8(AIN(I_LNX_B) + c0, lb);
    float gnw[8]; ldf8(AIN(I_GLA_NW) + (c0 & 127), gnw);
    for (int t = gw; t < T_ALL; t += NGW) {
        int pos, len; seq_pos(t, pos, len); const bool first = pos == 0, last = pos == len - 1;
        const bf16_t* P = PROJ + (size_t)t * PROJ_LD;
        float r[8], k[8], v[8], af[8], ab[8], yf[8], yb[8], g[8];
        shift8(P, c0, first, last, mpr, mnr, r); shift8(P, 512 + c0, first, last, mpk, mnk, k); shift8(P, 1024 + c0, first, last, mpv, mnv, v);
        ld8nt(LO + (size_t)t * 2048 + 1024 + c0, af); ld8nt(LO + (size_t)t * 2048 + 1536 + c0, ab);
        ld8nt(YF + (size_t)t * 512 + c0, yf); ld8nt(YB + (size_t)t * 512 + c0, yb); ld8nt(GB + (size_t)t * 512 + c0, g);
        float bon = 0.f, sy = 0.f;
#pragma unroll
        for (int j = 0; j < 8; ++j) { bon += r[j] * k[j] * (2.0f + (af[j] + ab[j] - 2.0f) * kav[j]) * rkv[j]; yf[j] += yb[j]; sy += yf[j]; }
        bon += __shfl_xor(bon, 1); sy += __shfl_xor(sy, 1); bon += __shfl_xor(bon, 2); sy += __shfl_xor(sy, 2); bon += __shfl_xor(bon, 4); sy += __shfl_xor(sy, 4);
        const float mean = sy * (1.0f / 64.0f);
        float sv = 0.f;
#pragma unroll
        for (int j = 0; j < 8; ++j) { yf[j] -= mean; sv += yf[j] * yf[j]; }
        sv += __shfl_xor(sv, 1); sv += __shfl_xor(sv, 2); sv += __shfl_xor(sv, 4);
        const float rstd = __builtin_amdgcn_rsqf(sv * (1.0f / 64.0f) + 64e-5f);
        float o[8];
#pragma unroll
        for (int j = 0; j < 8; ++j) o[j] = (yf[j] * rstd * lw[j] + lb[j] + bon * v[j]) * g[j];
        *(u32x4*)(MIX + (size_t)t * 1024 + c0) = st8(o);
        float of[8], gg[8];
        ld8nt(MIX + (size_t)t * 1024 + 512 + c0, of); ld8nt(P + 1952 + 1040 + c0, gg);
        float ss = 0.f;
#pragma unroll
        for (int j = 0; j < 8; ++j) ss += of[j] * of[j];
        ss += __shfl_xor(ss, 1); ss += __shfl_xor(ss, 2); ss += __shfl_xor(ss, 4); ss += __shfl_xor(ss, 8);
        const float rsg = __builtin_amdgcn_rsqf(ss * (1.0f / 128.0f) + 1e-5f);
#pragma unroll
        for (int j = 0; j < 8; ++j) o[j] = of[j] * rsg * gnw[j] * gg[j] * sigmoidf_(gg[j]);
        *(u32x4*)(MIX + (size_t)t * 1024 + 512 + c0) = st8(o);
    }
}

__device__ __forceinline__ void rowpass_phase(KA a, int G, int which, const int tid, const int bid) {
    const int wid = tid >> 6, lane = tid & 63;
    unsigned char* ws = AWS; float* sm = (float*)(ws + WS_SMALL);
    bf16_t* XBUF = (bf16_t*)(ws + WS_MO);
    const float* ssq = sm + (which == 0 ? OFF_SSQ1 : (which == 1 ? OFF_SSQ2 : OFF_SSQ3));
    const float* gp = AIN(which == 0 ? I_G_MIX_POST : (which == 1 ? I_G_X_POST : I_G_FFN_POST));
    float* rsout = sm + (which == 0 ? OFF_RS1 : OFF_RS2);
    const int gw = bid * 8 + wid, NGW = G * 8;
    f32x4 gv[4];
#pragma unroll
    for (int j = 0; j < 4; ++j) gv[j] = ((const f32x4*)gp)[lane + 64 * j];
    constexpr int NR = 3;
    for (int t0 = gw; t0 < T_ALL; t0 += NR * NGW) {
        int tt[NR]; float sc[NR]; f32x4 bvf[NR][4]; u32x2 bvh[NR][4], brw[NR][4];
#pragma unroll
        for (int q = 0; q < NR; ++q) {
            const int t = t0 + q * NGW < T_ALL ? t0 + q * NGW : t0; tt[q] = t;
            const bf16_t* BRp = which == 0 ? (const bf16_t*)(ws + WS_MO) + (size_t)t * DM : (which == 1 ? (const bf16_t*)(ws + WS_XO) + (size_t)t * DM
                              : (t < FO_SPLIT ? (const bf16_t*)(ws + WS_KB) + (size_t)t * DM : (const bf16_t*)(ws + WS_FO_HI) + (size_t)(t - FO_SPLIT) * DM));
            const u32x2* br = (const u32x2*)BRp + lane;
            const u32x2* xb = (const u32x2*)(XBUF + (size_t)t * DM) + lane;
            const f32x4* basef = (const f32x4*)xrow_ptr(a, t) + lane;
#pragma unroll
            for (int j = 0; j < 4; ++j) { if (which == 0) bvf[q][j] = __builtin_nontemporal_load(basef + 64 * j); else bvh[q][j] = __builtin_nontemporal_load(xb + 64 * j); brw[q][j] = __builtin_nontemporal_load(br + 64 * j); }
            sc[q] = ssq[t];
        }
#pragma unroll
        for (int q = 0; q < NR; ++q) {
            if (q > 0 && tt[q] == t0) continue;
            const int t = tt[q];
            const float scl = __builtin_amdgcn_rsqf(sc[q] * (1.0f / DM) + 1e-6f);
            u32x2* xb = (u32x2*)(XBUF + (size_t)t * DM) + lane;
            f32x4* orow = (f32x4*)(AOUT + (size_t)t * DM) + lane;
            f32x4 x[4]; float s = 0.f;
#pragma unroll
            for (int j = 0; j < 4; ++j) {
                f32x4 bv;
                if (which == 0) bv = bvf[q][j]; else { const u32x2 w1 = bvh[q][j]; bv = (f32x4){bflo(w1.x), bfhi(w1.x), bflo(w1.y), bfhi(w1.y)}; }
                const u32x2 w = brw[q][j];
                x[j].x = bv.x + bflo(w.x) * scl * gv[j].x; x[j].y = bv.y + bfhi(w.x) * scl * gv[j].y; x[j].z = bv.z + bflo(w.y) * scl * gv[j].z; x[j].w = bv.w + bfhi(w.y) * scl * gv[j].w;
                s += (x[j].x * x[j].x + x[j].y * x[j].y) + (x[j].z * x[j].z + x[j].w * x[j].w);
            }
            if (which == 2) {
#pragma unroll
                for (int j = 0; j < 4; ++j) __builtin_nontemporal_store(x[j], orow + 64 * j);
            } else {
                s = wave_sum(s);
#pragma unroll
                for (int j = 0; j < 4; ++j) { u32x2 w; w.x = pk2(x[j].x, x[j].y); w.y = pk2(x[j].z, x[j].w); xb[64 * j] = w; }
                if (lane == 0) rsout[t] = __builtin_amdgcn_rsqf(s * (1.0f / DM) + 1e-6f);
            }
        }
    }
}

__device__ __forceinline__ void xattn_phase(KA a, LAS unsigned char* lds, int G, const int tid, const int bid) {
    const int wid = __builtin_amdgcn_readfirstlane(tid >> 6), lane = tid & 63, fr = lane & 15, fq = lane >> 4;
    unsigned char* ws = AWS;
    const bf16_t* Q = (const bf16_t*)(ws + WS_Q); const bf16_t* KB = (const bf16_t*)(ws + WS_KB); const bf16_t* VTg = (const bf16_t*)(ws + WS_VT); bf16_t* OB = (bf16_t*)(ws + WS_OB);
    constexpr int KS = 264, VS = 68;
    LAS bf16_t* Ks = (LAS bf16_t*)lds;
    LAS bf16_t* Vs = Ks + 64 * KS;
    u32x4 stg[4];
#define XA_FETCH(u_, s_) do { const int qt_ = (u_) >> 2, h_ = (u_) & 3, r0_ = qt_ * 128; const int bi_ = r0_ < TP ? r0_ / 2048 : 8 + (r0_ - TP) / 4096; \
        if ((s_) < 4) { _Pragma("unroll") for (int i = 0; i < 4; ++i) { const int cidx = tid + 512 * i, r = cidx >> 5, c8 = cidx & 31; stg[i] = *(const u32x4*)(KB + (size_t)(bi_ * 256 + (s_) * 64 + r) * 1024 + h_ * 256 + c8 * 8); } } \
        else { _Pragma("unroll") for (int i = 0; i < 4; ++i) { const int cidx = tid + 512 * i, r = cidx >> 3, c8 = cidx & 7; stg[i] = *(const u32x4*)(VTg + (size_t)(h_ * 256 + r) * TM + bi_ * 256 + ((s_) - 4) * 64 + c8 * 8); } } } while (0)
#define XA_PUT_K() do { _Pragma("unroll") for (int i = 0; i < 4; ++i) { const int cidx = tid + 512 * i, r = cidx >> 5, c8 = cidx & 31; *(LAS u32x4*)(Ks + r * KS + c8 * 8) = stg[i]; } } while (0)
#define XA_PUT_V() do { _Pragma("unroll") for (int i = 0; i < 4; ++i) { const int cidx = tid + 512 * i, r = cidx >> 3, c8 = cidx & 7; *(LAS u32x2*)(Vs + r * VS + c8 * 8) = (u32x2){stg[i].x, stg[i].y}; *(LAS u32x2*)(Vs + r * VS + c8 * 8 + 4) = (u32x2){stg[i].z, stg[i].w}; } } while (0)
    if (bid < 2560) XA_FETCH(bid, 0);
    for (int u = bid; u < 2560; u += G) {
        const int qt = u >> 2, h = u & 3, row0 = qt * 128;
        const int qrow = row0 + 16 * wid + fr;
        bf16x8 qf[8];
#pragma unroll
        for (int ks = 0; ks < 8; ++ks) qf[ks] = __builtin_nontemporal_load((const bf16x8*)(Q + (size_t)qrow * 1024 + h * 256 + 32 * ks + 8 * fq));
        f32x4 accS[16];
#pragma unroll
        for (int n = 0; n < 16; ++n) accS[n] = (f32x4){0.f, 0.f, 0.f, 0.f};
#pragma unroll
        for (int kt = 0; kt < 4; ++kt) {
            BAR_LDS();
            XA_PUT_K();
            XA_FETCH(u, kt + 1);
            BAR_LDS();
#pragma unroll
            for (int n = 0; n < 4; ++n)
#pragma unroll
                for (int ks = 0; ks < 8; ++ks) { const bf16x8 kf = *(const LAS bf16x8*)(Ks + (16 * n + fr) * KS + 32 * ks + 8 * fq); accS[kt * 4 + n] = __builtin_amdgcn_mfma_f32_16x16x32_bf16(kf, qf[ks], accS[kt * 4 + n], 0, 0, 0); }
        }
        float mx = -3.0e38f;
#pragma unroll
        for (int n = 0; n < 16; ++n)
#pragma unroll
            for (int i = 0; i < 4; ++i) mx = fmaxf(mx, accS[n][i]);
        mx = fmaxf(mx, __shfl_xor(mx, 16)); mx = fmaxf(mx, __shfl_xor(mx, 32));
        float sum = 0.f;
#pragma unroll
        for (int n = 0; n < 16; ++n)
#pragma unroll
            for (int i = 0; i < 4; ++i) { const float p = __expf(accS[n][i] - mx); accS[n][i] = p; sum += p; }
        sum += __shfl_xor(sum, 16); sum += __shfl_xor(sum, 32);
        const float inv = __builtin_amdgcn_rcpf(sum);
        bf16x8 pf[8];
#pragma unroll
        for (int kb = 0; kb < 8; ++kb) { u32x4 w; w.x = pk2(accS[2 * kb][0], accS[2 * kb][1]); w.y = pk2(accS[2 * kb][2], accS[2 * kb][3]); w.z = pk2(accS[2 * kb + 1][0], accS[2 * kb + 1][1]); w.w = pk2(accS[2 * kb + 1][2], accS[2 * kb + 1][3]); pf[kb] = __builtin_bit_cast(bf16x8, w); }
        f32x4 accO[16];
#pragma unroll
        for (int n = 0; n < 16; ++n) accO[n] = (f32x4){0.f, 0.f, 0.f, 0.f};
        const int un = u + G;
#pragma unroll
        for (int k4 = 0; k4 < 4; ++k4) {
            BAR_LDS();
            XA_PUT_V();
            if (k4 < 3) XA_FETCH(u, 5 + k4); else if (un < 2560) XA_FETCH(un, 0);
            BAR_LDS();
#pragma unroll
            for (int kb = 0; kb < 2; ++kb)
#pragma unroll
                for (int dtile = 0; dtile < 16; ++dtile) {
                    const u32x2 lo = *(const LAS u32x2*)(Vs + (16 * dtile + fr) * VS + 32 * kb + 4 * fq), hi = *(const LAS u32x2*)(Vs + (16 * dtile + fr) * VS + 32 * kb + 16 + 4 * fq);
                    accO[dtile] = __builtin_amdgcn_mfma_f32_16x16x32_bf16(mk8(lo, hi), pf[k4 * 2 + kb], accO[dtile], 0, 0, 0);
                }
        }
        bf16_t* orow = OB + (size_t)qrow * 1024 + h * 256 + 4 * fq;
#pragma unroll
        for (int dtile = 0; dtile < 16; ++dtile) { u32x2 w; w.x = pk2(accO[dtile][0] * inv, accO[dtile][1] * inv); w.y = pk2(accO[dtile][2] * inv, accO[dtile][3] * inv); *(u32x2*)(orow + 16 * dtile) = w; }
    }
#undef XA_FETCH
#undef XA_PUT_K
#undef XA_PUT_V
}

#define XB_TMO      128
#define XB_XCNT(j)  (256  + 64 * (j))
#define XB_XSUB(j)  (1280 + 64 * (j))
#define XB_XGEN(j)  (2304 + 64 * (j))
#define XB_TOP      3328
#define XB_TOPGEN   3392
#define XB_SPIN_CAP (1u << 22)
__device__ __forceinline__ unsigned xb_ld(unsigned* p)              { return __hip_atomic_load(p, __ATOMIC_RELAXED, __HIP_MEMORY_SCOPE_AGENT); }
__device__ __forceinline__ unsigned xb_add(unsigned* p, unsigned v) { return __hip_atomic_fetch_add(p, v, __ATOMIC_RELAXED, __HIP_MEMORY_SCOPE_AGENT); }
__device__ __forceinline__ unsigned xb_xcc_id() { return (unsigned)__builtin_amdgcn_s_getreg((3 << 11) | 20) & 0xFu; }
#define XB_SPIN(cond, bar) do { unsigned _sp = 0; while (cond) { __builtin_amdgcn_s_sleep(1); \
    if ((++_sp & 255u) == 0u) { if (xb_ld(&(bar)[XB_TMO])) break; if (_sp > XB_SPIN_CAP) { atomicAdd(&(bar)[XB_TMO], 1u); break; } } } } while (0)
struct XcdBarrier { unsigned* bar; unsigned x; volatile LAS unsigned* st; };
__device__ __forceinline__ XcdBarrier xcd_barrier_post(unsigned* bar, volatile LAS unsigned* st, int tid) {
    XcdBarrier b; b.bar = bar; b.x = xb_xcc_id(); b.st = st;
    if (tid == 0) (void)xb_add(&bar[XB_XCNT(b.x)], 1u);
    return b;
}
__device__ __forceinline__ void xcd_barrier_complete(unsigned* bar, unsigned x, unsigned G, unsigned& nloc, unsigned& nx) {
    unsigned sum, cnt, mine, sp = 0u;
    for (;;) {
        sum = 0u; cnt = 0u; mine = 0u;
#pragma unroll
        for (unsigned j = 0; j < 16; ++j) { const unsigned c = xb_ld(&bar[XB_XCNT(j)]); sum += c; cnt += (c > 0u) ? 1u : 0u; mine = (j == x) ? c : mine; }
        if (sum == G) break;
        __builtin_amdgcn_s_sleep(1);
        if ((++sp & 255u) == 0u) { if (xb_ld(&bar[XB_TMO])) break; if (sp > XB_SPIN_CAP) { atomicAdd(&bar[XB_TMO], 1u); break; } }
    }
    nloc = mine > 0u ? mine : 1u; nx = cnt > 0u ? cnt : 1u;
}
__device__ __forceinline__ void xcd_barrier(const XcdBarrier& b, int tid, unsigned G) {
    asm volatile("s_waitcnt vmcnt(0)" ::: "memory");
    __syncthreads();
    if (tid == 0) {
        unsigned* bar = b.bar;
        __builtin_amdgcn_s_waitcnt(0);
        unsigned nloc = b.st[0], nx = b.st[1];
        if (nloc == 0u) { xcd_barrier_complete(bar, b.x, G, nloc, nx); b.st[0] = nloc; b.st[1] = nx; }
        const unsigned old = xb_add(&bar[XB_XSUB(b.x)], 1u);
        const unsigned gen = old / nloc;
        if (old + 1u == (gen + 1u) * nloc) {
            __builtin_amdgcn_fence(__ATOMIC_RELEASE, "agent");
            asm volatile("s_waitcnt vmcnt(0)" ::: "memory");
            const unsigned og = xb_add(&bar[XB_TOP], 1u);
            const unsigned tg = og / nx;
            if (og + 1u == (tg + 1u) * nx) xb_add(&bar[XB_TOPGEN], 1u);
            else XB_SPIN(xb_ld(&bar[XB_TOPGEN]) == tg, bar);
            __builtin_amdgcn_fence(__ATOMIC_ACQUIRE, "agent");
            xb_add(&bar[XB_XGEN(b.x)], 1u);
            asm volatile("s_waitcnt vmcnt(0)" ::: "memory");
        } else {
            XB_SPIN(xb_ld(&bar[XB_XGEN(b.x)]) == gen, bar);
            __builtin_amdgcn_fence(__ATOMIC_ACQUIRE, "agent");
            asm volatile("s_waitcnt vmcnt(0)" ::: "memory");
        }
    }
    __syncthreads();
}

__device__ __forceinline__ void build_gemm(KA a, int gi, pg8::Gemm& g) {
    unsigned char* ws = AWS;
    switch (gi) {
    case 0: g = pg8::Gemm{(const bf16_t*)(ws + WS_XB), (const bf16_t*)(ws + WS_WIN), T_ALL, 3584, 1024, 1024, 1024}; break;
    case 1: g = pg8::Gemm{(const bf16_t*)(ws + WS_MEMB), (const bf16_t*)(ws + WS_WKV), TM, 1024, 1024, 1024, 1024}; break;
    case 2: g = pg8::Gemm{(const bf16_t*)(ws + WS_WKV) + (size_t)1024 * 1024, (const bf16_t*)(ws + WS_MEMB), 1024, TM, 1024, 1024, 1024}; break;
    case 3: g = pg8::Gemm{(const bf16_t*)(ws + WS_AL), (const bf16_t*)(ws + WS_WL), T_ALL, 2048, 256, 512, 512}; break;
    case 9: g = pg8::Gemm{(const bf16_t*)(ws + WS_AL) + 256, (const bf16_t*)(ws + WS_WL) + (size_t)2048 * 512 + 256, T_ALL, 512, 256, 512, 512}; break;
    case 4: g = pg8::Gemm{(const bf16_t*)(ws + WS_MIXED), (const bf16_t*)(ws + WS_WOUT), T_ALL, 1024, 1024, 1024, 1024}; break;
    case 5: g = pg8::Gemm{(const bf16_t*)(ws + WS_MO), (const bf16_t*)(ws + WS_WQ), T_ALL, 1024, 1024, 1024, 1024}; break;
    case 6: g = pg8::Gemm{(const bf16_t*)(ws + WS_OB), (const bf16_t*)(ws + WS_WO), T_ALL, 1024, 1024, 1024, 1024}; break;
    case 7: g = pg8::Gemm{(const bf16_t*)(ws + WS_MO), (const bf16_t*)(ws + WS_W1), T_ALL, 4096, 1024, 1024, 1024}; break;
    default: g = pg8::Gemm{(const bf16_t*)(ws + WS_HID), (const bf16_t*)(ws + WS_W2), T_ALL, 1024, 4096, 4096, 4096}; break;
    }
}

__global__ void __launch_bounds__(512, 2) fwd_kernel(Args args_unused) {
    extern __shared__ __attribute__((aligned(16))) unsigned char lds_raw[];
    LAS unsigned char* lds = (LAS unsigned char*)lds_raw;
    cg::grid_group grid = cg::this_grid();
    KA a0 = (KA)__builtin_amdgcn_kernarg_segment_ptr();
    const int ph_lo = a0->ph_lo, ph_hi = a0->ph_hi;
    volatile LAS unsigned* xst = (volatile LAS unsigned*)(lds + 131072);
    if (threadIdx.x < 2) xst[threadIdx.x] = 0u;
    __syncthreads();
    unsigned* barw = (unsigned*)((unsigned char*)a0->ws);
    XcdBarrier xb; xb.bar = barw; xb.x = 0; xb.st = xst;
    for (int ph = ph_lo; ph < ph_hi; ++ph) {
        if (ph == 5 && SCAN_V == 2) continue;
        if (ph > ph_lo) {
            if (ph_lo == 0 && ph > 1) xcd_barrier(xb, threadIdx.x, gridDim.x);
            else { grid.sync(); if (ph_lo == 0) xb = xcd_barrier_post(barw, xst, threadIdx.x); }
        }
        KA a = (KA)__builtin_amdgcn_kernarg_segment_ptr();
        int tid = threadIdx.x, bid = blockIdx.x, G = gridDim.x;
        asm volatile("" : "+s"(a), "+v"(tid), "+s"(bid), "+s"(G));
        int g0 = 0, g1 = 0, gx = -1;
        switch (ph) {
        case 0: if (EN(0)) p0_phase(a, lds, G, tid, bid); if (DUP_PHASE == 0 || DUP_PHASE == 100) { __syncthreads(); p0_phase(a, lds, G, tid, bid); } break;
        case 1: g0 = 0; g1 = 3; break;
        case 2: if (EN(2)) p2_phase(a, G, tid, bid); if (DUP_PHASE == 2 || DUP_PHASE == 100) { __syncthreads(); p2_phase(a, G, tid, bid); } break;
        case 3: g0 = 3; g1 = 4; gx = 9; break;
        case 4: if (EN(4)) { if (SCAN_V == 1) scan_phase(a, lds, G, tid, bid); else if (bid < 160) scan2_phase(a, lds, G, tid, bid); else gla_phase(a, lds, G, tid, bid); }
                if (DUP_PHASE == 41 && bid < 160) { __syncthreads(); scan2_phase(a, lds, G, tid, bid); }
                if (DUP_PHASE == 42 && bid >= 160) { __syncthreads(); gla_phase(a, lds, G, tid, bid); } break;
        case 5: if (EN(5) && SCAN_V == 1) gla_phase(a, lds, G, tid, bid); break;
        case 6: if (EN(6)) combine_phase(a, G, tid, bid); if (DUP_PHASE == 6 || DUP_PHASE == 100) { __syncthreads(); combine_phase(a, G, tid, bid); } break;
        case 7: g0 = 4; g1 = 5; break;
        case 8: if (EN(8)) rowpass_phase(a, G, 0, tid, bid); break;
        case 9: g0 = 5; g1 = 6; break;
        case 10: if (EN(10)) xattn_phase(a, lds, G, tid, bid); if (DUP_PHASE == 10) { __syncthreads(); xattn_phase(a, lds, G, tid, bid); } break;
        case 11: g0 = 6; g1 = 7; break;
        case 12: if (EN(8)) rowpass_phase(a, G, 1, tid, bid); break;
        case 13: g0 = 7; g1 = 8; break;
        case 14: g0 = 8; g1 = 9; break;
        default: if (EN(8)) rowpass_phase(a, G, 2, tid, bid); if (DUP_PHASE == 15) { __syncthreads(); rowpass_phase(a, G, 2, tid, bid); } break;
        }
        if (EN(1)) for (int rep = 0; rep < ((DUP_PHASE == ph && g1 > g0) ? 2 : 1); ++rep) for (int gq = g0; gq < g1 + (gx >= 0 ? 1 : 0); ++gq) {
            const int gi = gq < g1 ? gq : gx;
            pg8::Gemm g; build_gemm(a, gi, g); pg8::EpiD E{gi};
            pg8::StaticOrder S; S.init(g.M, g.N, G, (gi == 1 || gi == 2) ? (G - 1 - bid) : bid);
            __syncthreads();
            pg8::gemm_phase(lds, g, S, E, tid);
        }
    }
}

extern "C" void kernel_launch(void* const* d_in, const int* in_sizes, int n_in, void* d_out, int out_size, void* d_ws, size_t ws_size, hipStream_t stream) {
    static int grid = 0;
    if (grid == 0) {
        int dev = 0, cus = 0, per_cu = 0;
        (void)hipGetDevice(&dev);
        (void)hipDeviceGetAttribute(&cus, hipDeviceAttributeMultiprocessorCount, dev);
        if (hipFuncSetAttribute((const void*)fwd_kernel, hipFuncAttributeMaxDynamicSharedMemorySize, LDS_BYTES) != hipSuccess) { fprintf(stderr, "hipFuncSetAttribute failed\n"); }
        if (hipOccupancyMaxActiveBlocksPerMultiprocessor(&per_cu, (const void*)fwd_kernel, 512, LDS_BYTES) != hipSuccess || per_cu < 1) per_cu = 1;
        (void)hipGetLastError();
        grid = cus * per_cu;
        if (grid > 256) grid = 256;
        if (grid < 1) grid = 256;
    }
    Args a{};
    for (int i = 0; i < 39; ++i) a.in[i] = (const float*)d_in[i];
    a.out = (float*)d_out; a.ws = (unsigned char*)d_ws;
#if MULTI_LAUNCH
    for (int ph = 0; ph < NPH; ++ph) {
        a.ph_lo = ph; a.ph_hi = ph + 1;
        void* args[] = {&a};
        hipError_t e = hipLaunchCooperativeKernel((const void*)fwd_kernel, dim3(grid), dim3(512), args, LDS_BYTES, stream);
        if (e != hipSuccess) { fprintf(stderr, "cooperative launch failed: %s (grid %d)\n", hipGetErrorString(e), grid); break; }
    }
#else
    a.ph_lo = 0; a.ph_hi = NPH;
    void* args[] = {&a};
    hipError_t e = hipLaunchCooperativeKernel((const void*)fwd_kernel, dim3(grid), dim3(512), args, LDS_BYTES, stream);
    if (e != hipSuccess) fprintf(stderr, "cooperative launch failed: %s (grid %d)\n", hipGetErrorString(e), grid);
#endif
}
```
